# Optimizing an MI355X kernel written in HIP

```python
import math
import jax
import jax.numpy as jnp
from jax import lax
import numpy as np

D_MODEL = 2048
BATCH = 4
SEQ = 4096
DEPTH = 1

HEAD_DIM = 128
ROPE_DIM = HEAD_DIM // 4
ROPE_THETA = 500000.0
BLK = 128
RMS_EPS = 1e-6
DIL_GROUPS = ((128, 1), (512, 4), (2048, 16))
N_DIL_GROUPS = len(DIL_GROUPS)
DIL_HEADS = 4
DIL_WIDTH = N_DIL_GROUPS * DIL_HEADS * HEAD_DIM
DIL_OUT = DIL_HEADS * HEAD_DIM
DIFF_HEADS = 4
DIFF_QK = DIFF_HEADS * 2 * HEAD_DIM
DIFF_OUT = DIFF_HEADS * 2 * HEAD_DIM
IN_SPLITS = (DIL_WIDTH, DIL_WIDTH, DIL_WIDTH, DIFF_QK, DIFF_QK, DIFF_OUT, D_MODEL, D_MODEL)
D_IN = sum(IN_SPLITS)
D_FF = 5632

kernel_name = 'hybrid_dilated_diff_macaron_layer'


def rms_norm(x, g):
    xf = x.astype(jnp.float32)
    y = xf * lax.rsqrt(jnp.mean(xf * xf, axis=-1, keepdims=True) + RMS_EPS)
    return (y * g.astype(jnp.float32)).astype(x.dtype)


def rope_tables(positions):
    inv = ROPE_THETA ** (-jnp.arange(0, ROPE_DIM, 2, dtype=jnp.float32) / ROPE_DIM)
    ang = positions.astype(jnp.float32)[..., None] * inv
    return jnp.cos(ang), jnp.sin(ang)


def apply_rope(x, cos, sin):
    shape = cos.shape[:2] + (1,) * (x.ndim - 3) + (cos.shape[-1],)
    c = cos.reshape(shape)
    s = sin.reshape(shape)
    half = ROPE_DIM // 2
    xr = x[..., :ROPE_DIM].astype(jnp.float32)
    x1, x2 = xr[..., :half], xr[..., half:]
    rot = jnp.concatenate([x1 * c - x2 * s, x2 * c + x1 * s], axis=-1)
    return jnp.concatenate([rot.astype(x.dtype), x[..., ROPE_DIM:]], axis=-1)


def swiglu(h, w_gate, w_up, w_down):
    return (jax.nn.silu(h @ w_gate) * (h @ w_up)) @ w_down


def lambda_init(layer):
    return 0.8 - 0.6 * math.exp(-0.3 * layer)


def dilated_group(q, k, v, window, dilation):
    B, S, H, D = q.shape
    band = window // dilation
    L = S // dilation
    pad = (-L) % BLK
    nb = (L + pad) // BLK

    def strided(t):
        return t.reshape(B, L, dilation, H, D).transpose(0, 2, 1, 3, 4)

    qb = jnp.pad(strided(q), ((0, 0), (0, 0), (0, pad), (0, 0), (0, 0))).reshape(B, dilation, nb, BLK, H, D)

    def band_blocks(t):
        t = jnp.pad(strided(t), ((0, 0), (0, 0), (BLK, pad), (0, 0), (0, 0)))
        t = t.reshape(B, dilation, nb + 1, BLK, H, D)
        return jnp.concatenate([t[:, :, :-1], t[:, :, 1:]], axis=3)

    kb = band_blocks(k)
    vb = band_blocks(v)
    s = jnp.einsum('brnqhd,brnkhd->brnhqk', qb, kb).astype(jnp.float32) * (D ** -0.5)
    qi = jnp.arange(BLK)[:, None]
    kj = jnp.arange(2 * BLK)[None, :]
    dist = qi - kj + BLK
    kpos = jnp.arange(nb)[:, None, None] * BLK + kj[None] - BLK
    valid = (dist >= 0) & (dist <= band) & (kpos >= 0)
    s = jnp.where(valid[None, None, :, None], s, -jnp.inf)
    m = jnp.max(s, axis=-1, keepdims=True)
    p = jnp.exp(s - m)
    den = jnp.sum(p, axis=-1, keepdims=True)
    o = jnp.einsum('brnhqk,brnkhd->brnqhd', (p / den).astype(v.dtype), vb)
    lse = (m + jnp.log(den))[..., 0]
    o = o.reshape(B, dilation, nb * BLK, H, D)[:, :, :L].transpose(0, 2, 1, 3, 4).reshape(B, S, H, D)
    lse = lse.transpose(0, 1, 2, 4, 3).reshape(B, dilation, nb * BLK, H)[:, :, :L]
    lse = lse.transpose(0, 2, 1, 3).reshape(B, S, H)
    return o, lse


def diff_attention(q, k, v, lam):
    B, S, H, _, D = q.shape
    nb = S // BLK
    qb = q.reshape(B, nb, BLK, H, 2, D).transpose(1, 0, 2, 3, 4, 5)
    kpos = jnp.arange(S)

    def block(args):
        qblk, i = args
        s = jnp.einsum('bqhcd,bkhcd->bhcqk', qblk, k).astype(jnp.float32) * (D ** -0.5)
        qpos = i * BLK + jnp.arange(BLK)
        s = jnp.where(kpos[None, :] <= qpos[:, None], s, -jnp.inf)
        p = jax.nn.softmax(s, axis=-1)
        a = p[:, :, 0] - lam * p[:, :, 1]
        return jnp.einsum('bhqk,bkhe->bqhe', a.astype(v.dtype), v)

    o = lax.map(block, (qb, jnp.arange(nb)))
    return o.transpose(1, 0, 2, 3, 4).reshape(B, S, H, 2 * D)


def hybrid_layer(x, cos, sin, layer, ffn1_norm, ffn1_w_gate, ffn1_w_up, ffn1_w_down, mix_norm, w_in,
                 dil_q_norm, dil_k_norm, diff_q_norm, diff_k_norm, diff_lq1, diff_lk1, diff_lq2, diff_lk2,
                 diff_subln, w_dil_branch, w_diff_branch, w_out, ffn2_norm, ffn2_w_gate, ffn2_w_up, ffn2_w_down):
    B, S, _ = x.shape
    x = x + 0.5 * swiglu(rms_norm(x, ffn1_norm), ffn1_w_gate, ffn1_w_up, ffn1_w_down)

    h = rms_norm(x, mix_norm)
    proj = h @ w_in
    idx = np.cumsum(IN_SPLITS)[:-1].tolist()
    dq, dk, dv, fq, fk, fv, g_dil, g_diff = jnp.split(proj, idx, axis=-1)

    gshape = (B, S, N_DIL_GROUPS, DIL_HEADS, HEAD_DIM)
    dq = apply_rope(rms_norm(dq.reshape(gshape), dil_q_norm), cos, sin)
    dk = apply_rope(rms_norm(dk.reshape(gshape), dil_k_norm), cos, sin)
    dv = dv.reshape(gshape)
    outs = []
    lses = []
    for g, (window, dilation) in enumerate(DIL_GROUPS):
        o_g, lse_g = dilated_group(dq[:, :, g], dk[:, :, g], dv[:, :, g], window, dilation)
        outs.append(o_g)
        lses.append(lse_g)
    mix_w = jax.nn.softmax(jnp.stack(lses, axis=0), axis=0).astype(x.dtype)
    o_dil = jnp.einsum('gbsh,gbshd->bshd', mix_w, jnp.stack(outs, axis=0)).reshape(B, S, DIL_OUT)

    fshape = (B, S, DIFF_HEADS, 2, HEAD_DIM)
    fq = apply_rope(rms_norm(fq.reshape(fshape), diff_q_norm), cos, sin)
    fk = apply_rope(rms_norm(fk.reshape(fshape), diff_k_norm), cos, sin)
    fv = fv.reshape(B, S, DIFF_HEADS, 2 * HEAD_DIM)
    lam_init = lambda_init(layer)
    lam = (jnp.exp(jnp.sum(diff_lq1.astype(jnp.float32) * diff_lk1.astype(jnp.float32)))
           - jnp.exp(jnp.sum(diff_lq2.astype(jnp.float32) * diff_lk2.astype(jnp.float32))) + lam_init)
    o_diff = diff_attention(fq, fk, fv, lam)
    o_diff = (rms_norm(o_diff, diff_subln) * (1.0 - lam_init)).reshape(B, S, DIFF_OUT)

    y = jax.nn.sigmoid(g_dil) * (o_dil @ w_dil_branch) + jax.nn.sigmoid(g_diff) * (o_diff @ w_diff_branch)
    x = x + y @ w_out

    x = x + 0.5 * swiglu(rms_norm(x, ffn2_norm), ffn2_w_gate, ffn2_w_up, ffn2_w_down)
    return x


def setup_inputs(seed: int = 0) -> dict:
    key = jax.random.key(seed)
    ks = jax.random.split(key, 32)
    f32 = jnp.float32

    def dense(k, fan_in, fan_out):
        return jax.random.normal(k, (DEPTH, fan_in, fan_out), f32) * fan_in ** -0.5

    def gain(k, n):
        return 1.0 + 0.02 * jax.random.normal(k, (DEPTH, n), f32)

    def small(k, n):
        return 0.1 * jax.random.normal(k, (DEPTH, n), f32)

    x = jax.random.normal(ks[0], (BATCH, SEQ, D_MODEL), f32)
    positions = (jnp.arange(SEQ, dtype=jnp.int32)[None, :]
                 + jax.random.randint(ks[1], (BATCH, 1), 0, 1024, dtype=jnp.int32))
    return {
        'x': x,
        'positions': positions,
        'ffn1_norm': gain(ks[2], D_MODEL),
        'ffn1_w_gate': dense(ks[3], D_MODEL, D_FF),
        'ffn1_w_up': dense(ks[4], D_MODEL, D_FF),
        'ffn1_w_down': dense(ks[5], D_FF, D_MODEL),
        'mix_norm': gain(ks[6], D_MODEL),
        'w_in': dense(ks[7], D_MODEL, D_IN),
        'dil_q_norm': gain(ks[8], HEAD_DIM),
        'dil_k_norm': gain(ks[9], HEAD_DIM),
        'diff_q_norm': gain(ks[10], HEAD_DIM),
        'diff_k_norm': gain(ks[11], HEAD_DIM),
        'diff_lq1': small(ks[12], HEAD_DIM),
        'diff_lk1': small(ks[13], HEAD_DIM),
        'diff_lq2': small(ks[14], HEAD_DIM),
        'diff_lk2': small(ks[15], HEAD_DIM),
        'diff_subln': gain(ks[16], 2 * HEAD_DIM),
        'w_dil_branch': dense(ks[17], DIL_OUT, D_MODEL),
        'w_diff_branch': dense(ks[18], DIFF_OUT, D_MODEL),
        'w_out': dense(ks[19], D_MODEL, D_MODEL),
        'ffn2_norm': gain(ks[20], D_MODEL),
        'ffn2_w_gate': dense(ks[21], D_MODEL, D_FF),
        'ffn2_w_up': dense(ks[22], D_MODEL, D_FF),
        'ffn2_w_down': dense(ks[23], D_FF, D_MODEL),
    }


def reference(x, positions, ffn1_norm, ffn1_w_gate, ffn1_w_up, ffn1_w_down, mix_norm, w_in,
              dil_q_norm, dil_k_norm, diff_q_norm, diff_k_norm, diff_lq1, diff_lk1, diff_lq2, diff_lk2,
              diff_subln, w_dil_branch, w_diff_branch, w_out, ffn2_norm, ffn2_w_gate, ffn2_w_up, ffn2_w_down):
    cos, sin = rope_tables(positions)
    for l in range(DEPTH):
        x = hybrid_layer(x, cos, sin, l, ffn1_norm[l], ffn1_w_gate[l], ffn1_w_up[l], ffn1_w_down[l],
                         mix_norm[l], w_in[l], dil_q_norm[l], dil_k_norm[l], diff_q_norm[l], diff_k_norm[l],
                         diff_lq1[l], diff_lk1[l], diff_lq2[l], diff_lk2[l], diff_subln[l],
                         w_dil_branch[l], w_diff_branch[l], w_out[l], ffn2_norm[l], ffn2_w_gate[l],
                         ffn2_w_up[l], ffn2_w_down[l])
    return x
```

```cpp
#include <hip/hip_runtime.h>
#include <hip/hip_cooperative_groups.h>
#include <cstdio>
#include <cstdint>
namespace cg = cooperative_groups;
#ifndef ONE_LAUNCH
#define ONE_LAUNCH 1
#endif
namespace pg8 {
#define PG8_LAS __attribute__((address_space(3)))
typedef unsigned short bf16_t;
typedef short bf16x8 __attribute__((ext_vector_type(8)));
typedef float f32x4 __attribute__((ext_vector_type(4)));
typedef unsigned u32x4 __attribute__((ext_vector_type(4)));
constexpr int BM = 256, BK = 64, HALF = 128, HTB = HALF * BK * 2  , STAGE_BYTES = 8 * HTB, NXCD = 8, WGM = 8;

__host__ __device__ __forceinline__ int lds_byte(int r, int c) { const int st = (r >> 4) * 2 + (c >> 5), rr = r & 15, cc = c & 31, ob = rr * 64 + cc * 2; return st * 1024 + (ob ^ (((ob >> 9) & 1) << 5)); }
__host__ __device__ __forceinline__ void stage_rc(int b, int& R, int& C) { const int st = b / 1024, sb = b % 1024, swz = sb ^ (((sb >> 9) & 1) << 5); R = (st >> 1) * 16 + swz / 64; C = (st & 1) * 32 + (swz % 64) / 2; }
__host__ __device__ __forceinline__ int perm32(int rho) { const int n = rho >> 4, i = rho & 15; return 8 * (i >> 2) + 4 * n + (i & 3); }

struct Unit { int pm, pn; };
struct Gemm { const bf16_t* A; const bf16_t* Bt; int M, N, K; };

struct StaticOrder {
    int nM, nN, nwg, G, c;
    __host__ __device__ void init(int M, int N, int G_, int c_) { nM = M / BM; nN = N / BM; nwg = nM * nN; G = G_; c = c_; }
    __host__ __device__ bool next(int i, Unit& u) const {
        const long L = (long)i * G + c; if (L >= nwg) return false;
        int wgid = (int)L; { const int q = nwg / NXCD, r = nwg % NXCD, xcd = wgid % NXCD, off = wgid / NXCD; wgid = (xcd < r ? xcd * (q + 1) : r * (q + 1) + (xcd - r) * q) + off; }
        const int nig = WGM * nN, gid = wgid / nig, fm = gid * WGM, gsz = (nM - fm) < WGM ? (nM - fm) : WGM;
        u.pm = fm + ((wgid % nig) % gsz); u.pn = (wgid % nig) / gsz; return true;
    }
    __device__ __forceinline__ void a_ready(const Unit&) const {}
    __device__ __forceinline__ void done(const Unit&) const {}
};
__device__ __forceinline__ unsigned cvt_pk_bf16(float lo, float hi) { unsigned r; asm volatile("v_cvt_pk_bf16_f32 %0, %1, %2" : "=v"(r) : "v"(lo), "v"(hi)); return r; }
constexpr float RMS_EPS = 1e-6f;
__device__ __forceinline__ float fast_sigmoid(float g) { return __builtin_amdgcn_rcpf(1.0f + __builtin_amdgcn_exp2f(-1.4426950408889634f * g)); }
__device__ __forceinline__ f32x4 bf2f_lo(unsigned a, unsigned b) { f32x4 r; r[0] = __uint_as_float(a << 16); r[1] = __uint_as_float(a & 0xffff0000u); r[2] = __uint_as_float(b << 16); r[3] = __uint_as_float(b & 0xffff0000u); return r; }

struct EpiSwiglu {
    static constexpr bool PERM = true, AFTER_DRAIN = false;
    bf16_t* H; int ldh; const float* ss;
    __device__ __forceinline__ void operator()(const f32x4 (&acc)[2][2][4][2], const Unit& u, int wr, int wc, int fr, int fq) const {
        const int row0 = u.pm * BM + wr * 64 + fr, col0 = u.pn * HALF + wc * 32 + 8 * fq;
#pragma unroll
        for (int ai = 0; ai < 2; ++ai)
#pragma unroll
            for (int m = 0; m < 4; ++m) { const int row = row0 + ai * HALF + m * 16; const float rs = rsqrtf(ss[row] * (1.0f / 2048.0f) + RMS_EPS);
                float h[8];
#pragma unroll
                for (int n = 0; n < 2; ++n)
#pragma unroll
                    for (int j = 0; j < 4; ++j) { const float g = acc[ai][0][m][n][j] * rs, up = acc[ai][1][m][n][j] * rs; h[n * 4 + j] = g * fast_sigmoid(g) * up; }
                u32x4 w; w.x = cvt_pk_bf16(h[0], h[1]); w.y = cvt_pk_bf16(h[2], h[3]); w.z = cvt_pk_bf16(h[4], h[5]); w.w = cvt_pk_bf16(h[6], h[7]);
                *(u32x4*)(H + (size_t)row * ldh + col0) = w; }
    }
};
struct EpiResid {
    static constexpr bool PERM = true, AFTER_DRAIN = false;
    const float* base; float* out; bf16_t* xb; float* ss; float alpha; int ld;
    __device__ __forceinline__ void operator()(const f32x4 (&acc)[2][2][4][2], const Unit& u, int wr, int wc, int fr, int fq) const {
        const int row0 = u.pm * BM + wr * 64 + fr, col0 = u.pn * BM + wc * 32 + 8 * fq;
#pragma unroll
        for (int ai = 0; ai < 2; ++ai)
#pragma unroll
            for (int m = 0; m < 4; ++m) { const int row = row0 + ai * HALF + m * 16; float s = 0.f;
#pragma unroll
                for (int bj = 0; bj < 2; ++bj) { const size_t p = (size_t)row * ld + col0 + bj * HALF;
                    const f32x4 b0 = *(const f32x4*)(base + p), b1 = *(const f32x4*)(base + p + 4);
                    const f32x4 v0 = b0 + acc[ai][bj][m][0] * alpha, v1 = b1 + acc[ai][bj][m][1] * alpha;
                    *(f32x4*)(out + p) = v0; *(f32x4*)(out + p + 4) = v1;
                    if (xb) { u32x4 w; w.x = cvt_pk_bf16(v0[0], v0[1]); w.y = cvt_pk_bf16(v0[2], v0[3]); w.z = cvt_pk_bf16(v1[0], v1[1]); w.w = cvt_pk_bf16(v1[2], v1[3]); *(u32x4*)(xb + p) = w; }
                    s += (v0[0] * v0[0] + v0[1] * v0[1]) + (v0[2] * v0[2] + v0[3] * v0[3]) + (v1[0] * v1[0] + v1[1] * v1[1]) + (v1[2] * v1[2] + v1[3] * v1[3]); }
                if (ss) { s += __shfl_xor(s, 16); s += __shfl_xor(s, 32); if (fq == 0) atomicAdd(ss + row, s); } }
    }
};
struct EpiScaleSplit {
    static constexpr bool PERM = true, AFTER_DRAIN = false;
    bf16_t* O0; int ld0; bf16_t* O1; int ld1; int split_pn; const float* ss;
    __device__ __forceinline__ void operator()(const f32x4 (&acc)[2][2][4][2], const Unit& u, int wr, int wc, int fr, int fq) const {
        const int row0 = u.pm * BM + wr * 64 + fr; const bool first = u.pn < split_pn;
        bf16_t* O = first ? O0 : O1; const int ld = first ? ld0 : ld1; const int col0 = (first ? u.pn : u.pn - split_pn) * BM + wc * 32 + 8 * fq;
#pragma unroll
        for (int ai = 0; ai < 2; ++ai)
#pragma unroll
            for (int m = 0; m < 4; ++m) { const int row = row0 + ai * HALF + m * 16; const float rs = rsqrtf(ss[row] * (1.0f / 2048.0f) + RMS_EPS);
#pragma unroll
                for (int bj = 0; bj < 2; ++bj) { const f32x4 v0 = acc[ai][bj][m][0] * rs, v1 = acc[ai][bj][m][1] * rs;
                    u32x4 w; w.x = cvt_pk_bf16(v0[0], v0[1]); w.y = cvt_pk_bf16(v0[2], v0[3]); w.z = cvt_pk_bf16(v1[0], v1[1]); w.w = cvt_pk_bf16(v1[2], v1[3]);
                    *(u32x4*)(O + (size_t)row * ld + col0 + bj * HALF) = w; } }
    }
};
template <bool ADD> struct EpiGate {
    static constexpr bool PERM = true, AFTER_DRAIN = false;
    const bf16_t* gate; int ldg, goff; bf16_t* Y; int ldy;
    __device__ __forceinline__ void operator()(const f32x4 (&acc)[2][2][4][2], const Unit& u, int wr, int wc, int fr, int fq) const {
        const int row0 = u.pm * BM + wr * 64 + fr, col0 = u.pn * BM + wc * 32 + 8 * fq;
#pragma unroll
        for (int ai = 0; ai < 2; ++ai)
#pragma unroll
            for (int m = 0; m < 4; ++m) { const int row = row0 + ai * HALF + m * 16;
#pragma unroll
                for (int bj = 0; bj < 2; ++bj) { const int col = col0 + bj * HALF;
                    const u32x4 gw = *(const u32x4*)(gate + (size_t)row * ldg + goff + col);
                    const f32x4 g0 = bf2f_lo(gw.x, gw.y), g1 = bf2f_lo(gw.z, gw.w);
                    f32x4 v0, v1;
#pragma unroll
                    for (int j = 0; j < 4; ++j) { v0[j] = fast_sigmoid(g0[j]) * acc[ai][bj][m][0][j]; v1[j] = fast_sigmoid(g1[j]) * acc[ai][bj][m][1][j]; }
                    bf16_t* yp = Y + (size_t)row * ldy + col;
                    if (ADD) { const u32x4 pw = *(const u32x4*)yp; v0 = v0 + bf2f_lo(pw.x, pw.y); v1 = v1 + bf2f_lo(pw.z, pw.w); }
                    u32x4 w; w.x = cvt_pk_bf16(v0[0], v0[1]); w.y = cvt_pk_bf16(v0[2], v0[3]); w.z = cvt_pk_bf16(v1[0], v1[1]); w.w = cvt_pk_bf16(v1[2], v1[3]);
                    *(u32x4*)yp = w; } }
    }
};

template <class Epi, class Sched, bool ALIGN_EPI = false, bool SP2 = false>
__device__ __forceinline__ void gemm_phase(PG8_LAS unsigned char* lds, const Gemm g, const Sched& S, const Epi& E) {
    int tid_ = threadIdx.x; asm volatile("" : "+v"(tid_));
    const int tid = tid_, wid = __builtin_amdgcn_readfirstlane(tid >> 6), lane = tid & 63, wr = wid >> 2, wc = wid & 3, fr = lane & 15, fq = lane >> 4;
    const int K = g.K, nt = K / BK;
    unsigned voffA[2], voffB[2];
#pragma unroll
    for (int i = 0; i < 2; ++i) { int R, C; stage_rc(tid * 16 + i * 8192, R, C); const int Rb = Epi::PERM ? ((R & ~31) + perm32(R & 31)) : R;
        voffA[i] = (unsigned)(R * K + C) * 2u; voffB[i] = (unsigned)(Rb * K + C) * 2u; }
    const size_t kstep = (size_t)(BK * 2);
    const size_t hstep = (size_t)HALF * K * 2;
    const size_t tstep = 2 * hstep;
    const unsigned ldsw = (unsigned)wid * 1024u;
    const int aoff = lds_byte(wr * 64 + fr, fq * 8), boff = lds_byte(wc * 32 + fr, fq * 8);
#define PG8_SA(b, h) (((b) * 2 + (h)) * HTB)
#define PG8_SB(b, h) ((4 + (b) * 2 + (h)) * HTB)
#define PG8_STAGE(bufoff, gbase, voff) do { _Pragma("unroll") for (int _i = 0; _i < 2; ++_i) \
        __builtin_amdgcn_global_load_lds((const unsigned*)((const char*)(gbase) + (voff)[_i]), (PG8_LAS unsigned*)(lds + (bufoff) + ldsw + _i * 8192), 16, 0, 0); } while (0)
#define PG8_LDA(dst, b, h) do { _Pragma("unroll") for (int m = 0; m < 4; ++m) _Pragma("unroll") for (int k = 0; k < 2; ++k) dst[m][k] = *(const PG8_LAS bf16x8*)(lds + PG8_SA(b, h) + aoff + m * 2048 + k * 1024); } while (0)
#define PG8_LDB(dst, b, h) do { _Pragma("unroll") for (int n = 0; n < 2; ++n) _Pragma("unroll") for (int k = 0; k < 2; ++k) dst[n][k] = *(const PG8_LAS bf16x8*)(lds + PG8_SB(b, h) + boff + n * 2048 + k * 1024); } while (0)
#define PG8_MMA(ai, bj, At, Bt) do { __builtin_amdgcn_s_setprio(1); _Pragma("unroll") for (int m = 0; m < 4; ++m) _Pragma("unroll") for (int n = 0; n < 2; ++n) _Pragma("unroll") for (int k = 0; k < 2; ++k) \
        acc[ai][bj][m][n] = __builtin_amdgcn_mfma_f32_16x16x32_bf16(Bt[n][k], At[m][k], acc[ai][bj][m][n], 0, 0, 0); __builtin_amdgcn_s_setprio(0); } while (0)
#define PG8_WAIT_V(n) asm volatile("s_waitcnt vmcnt(" #n ")" ::: "memory")
#define PG8_WAIT_L(n) asm volatile("s_waitcnt lgkmcnt(" #n ")" ::: "memory")
#define PG8_BAR __builtin_amdgcn_s_barrier()
#define PG8_SCHED __builtin_amdgcn_sched_barrier(0)
    Unit cur, nxt; int ui = 0;
    if (!S.next(0, cur)) return;
    f32x4 acc[2][2][4][2];
#pragma unroll
    for (int a = 0; a < 2; ++a)
#pragma unroll
        for (int b = 0; b < 2; ++b)
#pragma unroll
            for (int m = 0; m < 4; ++m)
#pragma unroll
                for (int n = 0; n < 2; ++n) acc[a][b][m][n] = (f32x4){0.f, 0.f, 0.f, 0.f};
    bf16x8 At[4][2], B0[2][2], B1[2][2];
    const char* cA = (const char*)g.A + (size_t)cur.pm * tstep; const char* cB = (const char*)g.Bt + (size_t)cur.pn * tstep;
    S.a_ready(cur);
    if constexpr (SP2) {
        PG8_STAGE(PG8_SB(0, 0), cB, voffB); PG8_STAGE(PG8_SB(0, 1), cB + hstep, voffB); PG8_STAGE(PG8_SA(0, 0), cA, voffA); PG8_STAGE(PG8_SA(0, 1), cA + hstep, voffA);
        if (wr == 1) PG8_BAR;
        PG8_WAIT_V(2); PG8_BAR;
        PG8_STAGE(PG8_SB(1, 0), cB + kstep, voffB); PG8_STAGE(PG8_SA(1, 0), cA + kstep, voffA); PG8_STAGE(PG8_SB(1, 1), cB + hstep + kstep, voffB);
        PG8_WAIT_V(6); PG8_BAR;
    } else {
        PG8_STAGE(PG8_SB(0, 0), cB, voffB); PG8_STAGE(PG8_SA(0, 0), cA, voffA); PG8_STAGE(PG8_SB(0, 1), cB + hstep, voffB); PG8_STAGE(PG8_SA(0, 1), cA + hstep, voffA);
        if (wr == 1) PG8_BAR;
        PG8_WAIT_V(4); PG8_BAR;
        PG8_STAGE(PG8_SB(1, 0), cB + kstep, voffB); PG8_STAGE(PG8_SA(1, 0), cA + kstep, voffA); PG8_STAGE(PG8_SB(1, 1), cB + hstep + kstep, voffB);
        PG8_WAIT_V(6); PG8_BAR;
    }
    for (;;) {
        const bool has_next = S.next(ui + 1, nxt);
        const char* nA = has_next ? (const char*)g.A + (size_t)nxt.pm * tstep : cA; const char* nB = has_next ? (const char*)g.Bt + (size_t)nxt.pn * tstep : cB;
        for (int t = 0; t < nt; t += 2) {
            const bool last = (t == nt - 2);
            const char* a1 = cA + (size_t)(t + 1) * kstep;
            const char* a2 = last ? nA : cA + (size_t)(t + 2) * kstep; const char* b2 = last ? nB : cB + (size_t)(t + 2) * kstep;
            const char* a3 = a2 + kstep; const char* b3 = b2 + kstep;
            if (last && has_next) S.a_ready(nxt);
            if constexpr (SP2) {
            PG8_LDB(B0, 0, 0); PG8_LDB(B1, 0, 1); PG8_SCHED; PG8_LDA(At, 0, 0); PG8_STAGE(PG8_SA(1, 1), a1 + hstep, voffA);
            PG8_WAIT_V(8); PG8_WAIT_L(0); PG8_BAR; PG8_MMA(0, 0, At, B0); PG8_MMA(0, 1, At, B1); PG8_BAR; PG8_SCHED;
            PG8_LDA(At, 0, 1); PG8_STAGE(PG8_SB(0, 0), b2, voffB); PG8_STAGE(PG8_SB(0, 1), b2 + hstep, voffB); PG8_STAGE(PG8_SA(0, 0), a2, voffA);
            PG8_WAIT_V(8); PG8_WAIT_L(0); PG8_BAR; PG8_MMA(1, 0, At, B0); PG8_MMA(1, 1, At, B1); PG8_BAR; PG8_SCHED;
            PG8_LDB(B0, 1, 0); PG8_LDB(B1, 1, 1); PG8_SCHED; PG8_LDA(At, 1, 0); PG8_STAGE(PG8_SA(0, 1), a2 + hstep, voffA);
            PG8_WAIT_V(8); PG8_WAIT_L(0); PG8_BAR; PG8_MMA(0, 0, At, B0); PG8_MMA(0, 1, At, B1); PG8_BAR; PG8_SCHED;
            PG8_LDA(At, 1, 1); PG8_STAGE(PG8_SB(1, 0), b3, voffB); PG8_STAGE(PG8_SB(1, 1), b3 + hstep, voffB); PG8_STAGE(PG8_SA(1, 0), a3, voffA);
            PG8_WAIT_V(8); PG8_WAIT_L(0); PG8_BAR; PG8_MMA(1, 0, At, B0); PG8_MMA(1, 1, At, B1); PG8_BAR; PG8_SCHED;
            } else {
            PG8_LDB(B0, 0, 0); PG8_SCHED; PG8_LDA(At, 0, 0); PG8_STAGE(PG8_SA(1, 1), a1 + hstep, voffA);
            PG8_WAIT_L(8); PG8_BAR; PG8_WAIT_L(0); PG8_MMA(0, 0, At, B0); PG8_BAR; PG8_SCHED;
            PG8_LDB(B1, 0, 1); PG8_STAGE(PG8_SB(0, 0), b2, voffB);
            PG8_BAR; PG8_WAIT_L(0); PG8_MMA(0, 1, At, B1); PG8_BAR;
            PG8_LDA(At, 0, 1); PG8_STAGE(PG8_SA(0, 0), a2, voffA);
            PG8_BAR; PG8_WAIT_L(0); PG8_MMA(1, 0, At, B0); PG8_BAR; PG8_SCHED;
            PG8_STAGE(PG8_SB(0, 1), b2 + hstep, voffB);
            PG8_WAIT_V(6); PG8_BAR; PG8_MMA(1, 1, At, B1); PG8_BAR;
            PG8_LDB(B0, 1, 0); PG8_SCHED; PG8_LDA(At, 1, 0); PG8_STAGE(PG8_SA(0, 1), a2 + hstep, voffA);
            PG8_WAIT_L(8); PG8_BAR; PG8_WAIT_L(0); PG8_MMA(0, 0, At, B0); PG8_BAR; PG8_SCHED;
            PG8_LDB(B1, 1, 1); PG8_STAGE(PG8_SB(1, 0), b3, voffB);
            PG8_BAR; PG8_WAIT_L(0); PG8_MMA(0, 1, At, B1); PG8_BAR;
            PG8_LDA(At, 1, 1); PG8_STAGE(PG8_SA(1, 0), a3, voffA);
            PG8_BAR; PG8_WAIT_L(0); PG8_MMA(1, 0, At, B0); PG8_BAR; PG8_SCHED;
            PG8_STAGE(PG8_SB(1, 1), b3 + hstep, voffB);
            PG8_WAIT_V(6); PG8_BAR; PG8_MMA(1, 1, At, B1); PG8_BAR;
            }
        }
        if constexpr (ALIGN_EPI) { if (wr == 0) PG8_BAR; }
        if constexpr (!Epi::AFTER_DRAIN) { E(acc, cur, wr, wc, fr, fq); S.done(cur); }
        if (!has_next) break;
#pragma unroll
        for (int a = 0; a < 2; ++a)
#pragma unroll
            for (int b = 0; b < 2; ++b)
#pragma unroll
                for (int m = 0; m < 4; ++m)
#pragma unroll
                    for (int n = 0; n < 2; ++n) acc[a][b][m][n] = (f32x4){0.f, 0.f, 0.f, 0.f};
        cur = nxt; cA = nA; cB = nB; ++ui;
        if constexpr (ALIGN_EPI) { if (wr == 1) PG8_BAR; }
    }
    PG8_WAIT_V(0);
    if constexpr (!ALIGN_EPI) { if (wr == 0) PG8_BAR; }
    PG8_BAR;
    if constexpr (Epi::AFTER_DRAIN) { E.fused(acc, cur, wr, wc, fr, fq, lds, wid, lane); S.done(cur); }
#undef PG8_SA
#undef PG8_SB
#undef PG8_STAGE
#undef PG8_LDA
#undef PG8_LDB
#undef PG8_MMA
#undef PG8_WAIT_V
#undef PG8_WAIT_L
#undef PG8_BAR
#undef PG8_SCHED
}
}
namespace att {
typedef unsigned short bf16_t;
typedef short bf16x8 __attribute__((ext_vector_type(8)));
typedef short s16x4 __attribute__((ext_vector_type(4)));
typedef float f32x16 __attribute__((ext_vector_type(16)));
typedef float f32x4 __attribute__((ext_vector_type(4)));
typedef unsigned u32x4 __attribute__((ext_vector_type(4)));
constexpr int D = 128;
constexpr float SCALE = 0.08838834764831845f;
constexpr float THR = 8.f;
constexpr int NW = 8, QBLK = 32, KVBLK = 64, QB = NW * QBLK;
constexpr int SHM_V = KVBLK * D * 2, SHM_K = KVBLK * D * 2;
constexpr int LDS_BYTES = 2 * SHM_V + 2 * SHM_K + NW * 64 * 4;

#define KSWZ(row, colB) ((row) * 256 + ((colB) ^ (((row) & 7) << 4)))
#define SBAR() __builtin_amdgcn_sched_barrier(0)
__device__ __forceinline__ int v_st(int k, int c) { const int kk = (k & ~0xC) | ((k & 4) << 1) | ((k & 8) >> 1); return ((kk >> 3) * 4 + (c >> 5)) * 512 + ((kk & 7) * 32 + (c & 31)) * 2; }
__device__ __forceinline__ int v_rd_base(int lane) { return ((lane & 3) << 3) | (((lane >> 2) & 3) << 6) | (((lane >> 4) & 1) << 5) | (((lane >> 5) & 1) << 8); }
constexpr int v_rd_off(int d0, int ks, int half) { return d0 * 512 + ks * 4096 + half * 2048; }
__device__ __forceinline__ int crow(int r, int hi) { return (r & 3) + 8 * (r >> 2) + 4 * hi; }
__device__ __forceinline__ unsigned cvtpk(float lo, float hi) { unsigned r; asm volatile("v_cvt_pk_bf16_f32 %0, %1, %2" : "=v"(r) : "v"(lo), "v"(hi)); return r; }
__device__ __forceinline__ bf16x8 ld8(const bf16_t* p) { return *reinterpret_cast<const bf16x8*>(p); }
__device__ __forceinline__ void mask_tile(f32x16& p0, f32x16& p1, int dq, unsigned W) {
    const float NEG = -__builtin_inff();
#pragma unroll
    for (int r = 0; r < 16; ++r) {
        const int c = (r & 3) + 8 * (r >> 2);
        if ((unsigned)(dq - c) >= W) p0[r] = NEG;
        if ((unsigned)(dq - c - 32) >= W) p1[r] = NEG;
    }
}
__device__ __forceinline__ void partialSM(f32x16& p0, f32x16& p1, float& m_reg, float& mn, float& alpha) {
    float pmax = p0[0]; for (int r = 1; r < 16; ++r) pmax = fmaxf(pmax, p0[r]); for (int r = 0; r < 16; ++r) pmax = fmaxf(pmax, p1[r]);
    { auto rr = __builtin_amdgcn_permlane32_swap(__float_as_uint(pmax), __float_as_uint(pmax), false, false);
      pmax = fmaxf(__uint_as_float(rr[0]), __uint_as_float(rr[1])); }
    constexpr float C2 = 1.4426950408889634f * SCALE;
    if (__builtin_expect(__all((pmax - m_reg) * SCALE <= THR), 1)) { mn = m_reg; alpha = 1.f; }
    else { mn = fmaxf(m_reg, pmax); alpha = __builtin_amdgcn_exp2f((m_reg - mn) * C2); m_reg = mn; }
    const float mnL = -mn * C2;
    for (int r = 0; r < 16; ++r) p0[r] = fmaf(p0[r], C2, mnL); for (int r = 0; r < 16; ++r) p1[r] = fmaf(p1[r], C2, mnL);
    for (int r = 0; r < 16; ++r) p0[r] = __builtin_amdgcn_exp2f(p0[r]);
}
__device__ __forceinline__ void finishSM(f32x16& p0, f32x16& p1, float alpha, float& l_reg, bf16x8& pa0, bf16x8& pa1, bf16x8& pa2, bf16x8& pa3) {
    for (int r = 0; r < 16; ++r) p1[r] = __builtin_amdgcn_exp2f(p1[r]);
    float ps = 0; for (int r = 0; r < 16; ++r) ps += p0[r]; for (int r = 0; r < 16; ++r) ps += p1[r];
    { auto rr = __builtin_amdgcn_permlane32_swap(__float_as_uint(ps), __float_as_uint(ps), false, false);
      ps = __uint_as_float(rr[0]) + __uint_as_float(rr[1]); }
    l_reg = l_reg * alpha + ps;
#define PK4(P, B_, OUT) do { unsigned a0 = cvtpk(P[B_+0], P[B_+1]), a1 = cvtpk(P[B_+2], P[B_+3]);                          \
        unsigned b0 = cvtpk(P[B_+4], P[B_+5]), b1 = cvtpk(P[B_+6], P[B_+7]);                                             \
        auto r0 = __builtin_amdgcn_permlane32_swap(a0, b0, false, false); auto r1 = __builtin_amdgcn_permlane32_swap(a1, b1, false, false); \
        u32x4 w = {r0[0], r1[0], r0[1], r1[1]}; OUT = *reinterpret_cast<bf16x8*>(&w); } while (0)
    PK4(p0, 0, pa0); PK4(p0, 8, pa1); PK4(p1, 0, pa2); PK4(p1, 8, pa3);
#undef PK4
}
template <int KB>
__device__ __forceinline__ void qkt(f32x16& p0, f32x16& p1, const char* K_lds, int r32, int hi, const bf16x8* qr) {
    p0 = f32x16{}; p1 = f32x16{};
    const char* kb[4];
#pragma unroll
    for (int dd = 0; dd < 4; ++dd) kb[dd] = K_lds + KB * SHM_K + KSWZ(r32, (dd * 16 + hi * 8) * 2);
#pragma unroll
    for (int d0 = 0; d0 < 8; ++d0) { const char* a = kb[d0 & 3] + (d0 >> 2) * 128;
        bf16x8 b0 = *reinterpret_cast<const bf16x8*>(a);
        bf16x8 b1 = *reinterpret_cast<const bf16x8*>(a + 32 * 256);
        p0 = __builtin_amdgcn_mfma_f32_32x32x16_bf16(b0, qr[d0], p0, 0, 0, 0);
        p1 = __builtin_amdgcn_mfma_f32_32x32x16_bf16(b1, qr[d0], p1, 0, 0, 0); }
}
template <int VB>
__device__ __forceinline__ void pv_tile(f32x16* o, int vb0, bf16x8 pa0, bf16x8 pa1, bf16x8 pa2, bf16x8 pa3) {
#define TRRD(dst, off) asm volatile("ds_read_b64_tr_b16 %0, %1 offset:%2" : "=&v"(dst) : "v"(vb0), "i"(off) : "memory")
#define PV_D0(d0) do { s16x4 l0, l1, l2, l3, h0, h1, h2, h3; constexpr int b_ = VB * SHM_V + v_rd_off(d0, 0, 0);   \
        TRRD(l0, b_); TRRD(h0, b_ + 2048); TRRD(l1, b_ + 4096); TRRD(h1, b_ + 6144); TRRD(l2, b_ + 8192); TRRD(h2, b_ + 10240); TRRD(l3, b_ + 12288); TRRD(h3, b_ + 14336); \
        asm volatile("s_waitcnt lgkmcnt(0)" ::: "memory"); SBAR();   \
        o[d0] = __builtin_amdgcn_mfma_f32_32x32x16_bf16(pa0, (bf16x8){l0[0], l0[1], l0[2], l0[3], h0[0], h0[1], h0[2], h0[3]}, o[d0], 0, 0, 0);   \
        o[d0] = __builtin_amdgcn_mfma_f32_32x32x16_bf16(pa1, (bf16x8){l1[0], l1[1], l1[2], l1[3], h1[0], h1[1], h1[2], h1[3]}, o[d0], 0, 0, 0);   \
        o[d0] = __builtin_amdgcn_mfma_f32_32x32x16_bf16(pa2, (bf16x8){l2[0], l2[1], l2[2], l2[3], h2[0], h2[1], h2[2], h2[3]}, o[d0], 0, 0, 0);   \
        o[d0] = __builtin_amdgcn_mfma_f32_32x32x16_bf16(pa3, (bf16x8){l3[0], l3[1], l3[2], l3[3], h3[0], h3[1], h3[2], h3[3]}, o[d0], 0, 0, 0); } while (0)
    PV_D0(0); PV_D0(1); PV_D0(2); PV_D0(3);
#undef PV_D0
#undef TRRD
}

struct BlockRef { const bf16_t* Q; const bf16_t* K; const bf16_t* V; bf16_t* O; float* LSE; int rs, os, ls, P0, W, skv; };
struct Seam { bf16x8 qr[8]; bf16x8 st_v0, st_v1, st_k0, st_k1; };
__device__ __forceinline__ int swa_jlo(int P0, int W) { const int lowk = P0 - W + 1; return lowk > 0 ? lowk / KVBLK : 0; }
#define VMW() asm volatile("s_waitcnt vmcnt(0)" ::: "memory")
#define VMWN(n) asm volatile("s_waitcnt vmcnt(%0)" :: "i"(n) : "memory")
#define SLOAD_H(Kp, Vp, RS, k0) do { const bf16_t* kq_ = (Kp) + (size_t)(k0) * (RS); const bf16_t* vq_ = (Vp) + (size_t)(k0) * (RS); const int o0_ = sr * (RS) + sc, o1_ = (32 + sr) * (RS) + sc; \
                         S.st_v0 = ld8(vq_ + o0_); S.st_v1 = ld8(vq_ + o1_); S.st_k0 = ld8(kq_ + o0_); S.st_k1 = ld8(kq_ + o1_); } while (0)
#define SWRITE_HK(bf) do { *(bf16x8*)(K_lds + (bf) * SHM_K + kws) = S.st_k0; *(bf16x8*)(K_lds + (bf) * SHM_K + kws + 32 * 256) = S.st_k1; } while (0)
#define SWRITE_HV(bf) do { *(bf16x8*)(V_lds + (bf) * SHM_V + vst0) = S.st_v0; *(bf16x8*)(V_lds + (bf) * SHM_V + vst1) = S.st_v1; } while (0)
#define SWRITE_H(bf) do { SWRITE_HV(bf); SWRITE_HK(bf); } while (0)
__device__ __forceinline__ void attn_prime(const BlockRef& cur, char* lds, Seam& S) {
    int tid_ = threadIdx.x; asm volatile("" : "+v"(tid_));
    const int tid = tid_, wid = __builtin_amdgcn_readfirstlane(tid >> 6), lane = tid & 63, r32 = lane & 31, hi = lane >> 5;
    const int sr = tid >> 4, sc = (tid & 15) * 8, kws = KSWZ(sr, sc * 2); char* K_lds = lds + 2 * SHM_V;
    const int kb0 = swa_jlo(cur.P0, cur.W) * KVBLK;
    for (int d0 = 0; d0 < 8; ++d0) S.qr[d0] = ld8(cur.Q + (size_t)(wid * QBLK + r32) * cur.rs + d0 * 16 + hi * 8);
    SLOAD_H(cur.K, cur.V, cur.rs, kb0); VMW(); SWRITE_HK(0);
    __syncthreads();
}
__device__ __forceinline__ void attn_block(const BlockRef& cur, const BlockRef& nxt, char* lds, Seam& S) {
    int tid_ = threadIdx.x; asm volatile("" : "+v"(tid_));
    const int tid = tid_, wid = __builtin_amdgcn_readfirstlane(tid >> 6), lane = tid & 63, r32 = lane & 31, hi = lane >> 5;
    const int W = cur.W, skv = cur.skv, RS = cur.rs;
    const int j_lo = swa_jlo(cur.P0, W);
    int j_hi = (cur.P0 + QB - 1) / KVBLK + 1; if (j_hi > skv / KVBLK) j_hi = skv / KVBLK;
    const int NT = j_hi - j_lo;
    const int kbn = swa_jlo(nxt.P0, nxt.W) * KVBLK;
    const int qlo = cur.P0 + wid * QBLK, qm = qlo + r32 - 4 * hi;
    char* V_lds = lds; char* K_lds = lds + 2 * SHM_V;
    float* ws = (float*)(lds + 2 * SHM_V + 2 * SHM_K) + wid * 64; float* li_l = ws, * al_l = ws + 32;
    float m_reg = -1e30f, l_reg = 0; f32x16 o[4] = {};
    const int sr = tid >> 4, sc = (tid & 15) * 8, vst0 = v_st(sr, sc), vst1 = v_st(32 + sr, sc), kws = KSWZ(sr, sc * 2);
    const int vb0 = (int)(uintptr_t)V_lds + v_rd_base(lane);
    const bf16_t* Kh = cur.K; const bf16_t* Vh = cur.V;
#define RESC(a) do { if (__any((a) < 1.f)) { if (hi == 0) al_l[r32] = (a); asm volatile("s_waitcnt lgkmcnt(0)" ::: "memory");              \
                     for (int d_ = 0; d_ < 4; ++d_) for (int r = 0; r < 16; ++r) o[d_][r] *= al_l[crow(r, hi)]; } } while (0)
#define KBASE(t) ((j_lo + (t)) * KVBLK)
#define MASKT(P0_, P1_, t) do { const int kb_ = KBASE(t); if (kb_ + KVBLK - 1 > qlo || kb_ <= qlo + QBLK - 1 - W) mask_tile(P0_, P1_, qm - kb_, (unsigned)W); } while (0)
    constexpr int NQL = 8;
#define SEAM_K0() do { VMWN(NQL); SWRITE_HK(0); SBAR(); } while (0)
    f32x16 pA0, pA1, pB0, pB1; float mnA, mnB, alA, alB; bf16x8 pa0, pa1, pa2, pa3;
    SWRITE_HV(0); SBAR();
    if (NT > 1) { SLOAD_H(Kh, Vh, RS, KBASE(1)); }
    SBAR(); qkt<0>(pA0, pA1, K_lds, r32, hi, S.qr);
    MASKT(pA0, pA1, 0); partialSM(pA0, pA1, m_reg, mnA, alA);
    if (NT > 1) { VMW(); SWRITE_H(1); }
    __syncthreads();
#define HALF_STEP(PX0, PX1, mnX, alX, PY0, PY1, alY, t, KB, VB, SB) do {                                                      \
        SBAR(); qkt<KB>(PX0, PX1, K_lds, r32, hi, S.qr);                                                                      \
        finishSM(PY0, PY1, alY, l_reg, pa0, pa1, pa2, pa3); SBAR();                                                           \
        if ((t) + 1 < NT) { SLOAD_H(Kh, Vh, RS, KBASE((t) + 1)); SBAR(); }                                                    \
        pv_tile<VB>(o, vb0, pa0, pa1, pa2, pa3); MASKT(PX0, PX1, (t)); partialSM(PX0, PX1, m_reg, mnX, alX);                  \
        __syncthreads();                                                                                                      \
        if ((t) + 1 < NT) { VMW(); SWRITE_H(SB); }                                                                            \
        RESC(alX); __syncthreads(); } while (0)
    for (int t = 1; t + 1 < NT; t += 2) {
        HALF_STEP(pB0, pB1, mnB, alB, pA0, pA1, alA, t, 1, 0, 0);
        HALF_STEP(pA0, pA1, mnA, alA, pB0, pB1, alB, t + 1, 0, 1, 1);
    }
    const bool even = (NT & 1) == 0;
    if (even) { SBAR(); qkt<1>(pB0, pB1, K_lds, r32, hi, S.qr); SBAR(); }
    SLOAD_H(nxt.K, nxt.V, nxt.rs, kbn); SBAR();
#pragma unroll
    for (int d0 = 0; d0 < 8; ++d0) S.qr[d0] = ld8(nxt.Q + (size_t)(wid * QBLK + r32) * nxt.rs + d0 * 16 + hi * 8);
    SBAR();
    finishSM(pA0, pA1, alA, l_reg, pa0, pa1, pa2, pa3); SBAR();
    pv_tile<0>(o, vb0, pa0, pa1, pa2, pa3);
    if (even) { MASKT(pB0, pB1, NT - 1); partialSM(pB0, pB1, m_reg, mnB, alB); __syncthreads(); RESC(alB);
        finishSM(pB0, pB1, alB, l_reg, pa0, pa1, pa2, pa3); SBAR(); pv_tile<1>(o, vb0, pa0, pa1, pa2, pa3); }
    SBAR(); SEAM_K0();
    if (hi == 0) li_l[r32] = l_reg; asm volatile("s_waitcnt lgkmcnt(0)" ::: "memory");
    if (cur.LSE && hi == 0) cur.LSE[(size_t)(wid * QBLK + r32) * cur.ls] = m_reg * SCALE + __logf(l_reg);
    float rli[16];
#pragma unroll
    for (int r = 0; r < 16; ++r) rli[r] = __builtin_amdgcn_rcpf(li_l[crow(r, hi)]);
    bf16_t* Ow = cur.O + (size_t)(wid * QBLK) * cur.os;
#pragma unroll
    for (int r = 0; r < 16; ++r) { const int orow = crow(r, hi);
#pragma unroll
        for (int d0 = 0; d0 < 4; ++d0) { const float v = o[d0][r] * rli[r];
            const float vn = __shfl_xor(v, 1);
            if ((r32 & 1) == 0) *(unsigned*)(Ow + (size_t)orow * cur.os + d0 * 32 + r32) = cvtpk(v, vn); } }
    __syncthreads();
#undef RESC
#undef KBASE
#undef MASKT
#undef SEAM_K0
#undef HALF_STEP
}
#undef VMW
#undef VMWN
#undef SLOAD_H
#undef SWRITE_HK
#undef SWRITE_HV
#undef SWRITE_H
}

#define GAS __attribute__((address_space(1)))
#define LAS __attribute__((address_space(3)))
typedef unsigned short bf16;
typedef unsigned v4u __attribute__((ext_vector_type(4)));
typedef unsigned v2u __attribute__((ext_vector_type(2)));
typedef float f32x4 __attribute__((ext_vector_type(4)));
#define LDS_WAIT() asm volatile("s_waitcnt lgkmcnt(0)" ::: "memory")
__device__ __forceinline__ unsigned f2bf(float f) { unsigned u = __builtin_bit_cast(unsigned, f); return (u + 0x7fffu + ((u >> 16) & 1u)) >> 16; }
__device__ __forceinline__ unsigned pk2(float lo, float hi) { return f2bf(lo) | (f2bf(hi) << 16); }
__device__ __forceinline__ float bflo(unsigned w) { return __uint_as_float(w << 16); }
__device__ __forceinline__ float bfhi(unsigned w) { return __uint_as_float(w & 0xffff0000u); }

constexpr int NB = 4, SEQ = 4096, DM = 2048, M = NB * SEQ, DFF = 5632, NQKV = 7680, NGATE = 4096, DIN = NQKV + NGATE;
constexpr int NWAVES = 8;
constexpr float RMS_EPS = 1e-6f;
constexpr float LAM_INIT = 0.2f;
constexpr size_t MiB = 1u << 20;
constexpr size_t WS_QKV = 0, WS_GATES = 240 * MiB;
constexpr size_t WS_W1GU = 0, WS_W1D = 44 * MiB, WS_HID = 66 * MiB;
constexpr size_t WS_XB = 368 * MiB;
constexpr size_t WS_ODIFF_RAW = 368 * MiB;
constexpr size_t WS_WIN = 432 * MiB;
constexpr size_t WS_ODIL_RAW = 432 * MiB;
constexpr size_t WS_LSE = 480 * MiB;
constexpr size_t WS_SS = 481 * MiB;
constexpr size_t WS_ROPE = 482 * MiB;
constexpr size_t WS_WOUT = 484 * MiB, WS_WDIL = 492 * MiB, WS_WDIFF = 494 * MiB;
constexpr size_t WS_W2GU = 0, WS_W2D = 44 * MiB, WS_ODIL = 66 * MiB, WS_ODIFF = 82 * MiB, WS_Y = 114 * MiB;
constexpr size_t WS_HID2 = 66 * MiB;
constexpr size_t WS_END = 498 * MiB;
constexpr int LDS_BYTES = 133120;

__device__ __forceinline__ float wave_sum(float v) {
#pragma unroll
    for (int o = 1; o < 64; o <<= 1) v += __shfl_xor(v, o);
    return v;
}
__device__ __forceinline__ void transpose_item(const float* W, int K, int N, const float* gain, bf16* WT, int mode, LAS float* scr, int item, int lane) {
    const int nblk = N / 32, kb = item / nblk, nb = item % nblk, k0 = 64 * kb, n0 = 32 * nb;
#pragma unroll 8
    for (int i = 0; i < 32; ++i) { const int kk = 2 * i + (lane >> 5); const float g = gain ? gain[k0 + kk] : 1.0f; scr[kk * 33 + (lane & 31)] = W[(size_t)(k0 + kk) * N + n0 + (lane & 31)] * g; }
    LDS_WAIT(); asm volatile("" ::: "memory");
    const int c = lane & 7;
    const int rbase = mode == 0 ? n0 : ((n0 >> 7) * 256 + (mode == 2 ? 128 : 0) + (n0 & 127));
#pragma unroll
    for (int j = 0; j < 4; ++j) { const int n = (lane >> 3) + 8 * j; const LAS float* s = scr + (8 * c) * 33 + n;
        v4u o; o.x = pk2(s[0 * 33], s[1 * 33]); o.y = pk2(s[2 * 33], s[3 * 33]); o.z = pk2(s[4 * 33], s[5 * 33]); o.w = pk2(s[6 * 33], s[7 * 33]);
        *(v4u*)(WT + (size_t)(rbase + n) * K + k0 + 8 * c) = o; }
    LDS_WAIT(); asm volatile("" ::: "memory");
}
__device__ __forceinline__ void transpose_mat(const float* W, int K, int N, const float* gain, bf16* WT, int mode, LAS float* scr, int gw, int NGW, int lane) {
    const int nit = (K / 64) * (N / 32);
    for (int it = gw; it < nit; it += NGW) transpose_item(W, K, N, gain, WT, mode, scr, it, lane);
}

struct Args { const float* in[24]; float* out; unsigned char* ws; int ph_lo, ph_hi; };
constexpr int NPHASE = 11;

__device__ __forceinline__ att::BlockRef attn_decode(int s, int w, int G, int nd, bf16* qkv, bf16* odiff_raw, bf16* odil_raw, float* lse) {
    att::BlockRef r;
    if (s < 2 * nd) {
        const int item = w + (s >> 1) * G, pass = s & 1, head = item >> 3, y = item & 7, qb = pass ? 15 - y : y;
        const int vh = head & 1, comp = (head >> 1) & 1, h = (head >> 2) & 3, b = head >> 4;
        bf16* base = qkv + (size_t)(b * SEQ) * NQKV;
        r.Q = base + 4608 + h * 256 + comp * 128 + (size_t)(qb * 256) * NQKV;
        r.K = base + 5632 + h * 256 + comp * 128;
        r.V = base + 6656 + h * 256 + vh * 128;
        r.O = odiff_raw + (size_t)comp * ((size_t)M * 1024) + (size_t)(b * SEQ + qb * 256) * 1024 + h * 256 + vh * 128;
        r.LSE = nullptr; r.rs = NQKV; r.os = 1024; r.ls = 0; r.P0 = qb * 256; r.W = 1 << 30; r.skv = SEQ;
    } else {
        const int blk = w + (s - 2 * nd) * G, g = blk >> 8, rem = blk & 255;
        const int dil = g == 0 ? 1 : (g == 1 ? 4 : 16), L = SEQ / dil, nqb = L / 256;
        const int qb = rem % nqb; int t = rem / nqb; const int c = t % dil; t /= dil; const int h = t & 3, b = t >> 2;
        const size_t tok0 = (size_t)b * SEQ + c;
        bf16* base = qkv + tok0 * NQKV + g * 512 + h * 128;
        r.Q = base + (size_t)(qb * 256) * ((size_t)dil * NQKV);
        r.K = base + 1536;
        r.V = base + 3072;
        r.O = odil_raw + (size_t)g * ((size_t)M * 512) + tok0 * 512 + h * 128 + (size_t)(qb * 256) * ((size_t)dil * 512);
        r.LSE = lse + (size_t)g * ((size_t)M * 4) + tok0 * 4 + h + (size_t)(qb * 256) * ((size_t)dil * 4);
        r.rs = dil * NQKV; r.os = dil * 512; r.ls = dil * 4; r.P0 = qb * 256; r.W = 129; r.skv = L;
    }
    return r;
}

__global__ void __launch_bounds__(NWAVES * 64, 2) layer_fwd(Args args) {
    extern __shared__ __attribute__((aligned(16))) unsigned char lds[];
    const int wave = __builtin_amdgcn_readfirstlane((int)threadIdx.x >> 6);
#define PHASE_TID() int tid_ = threadIdx.x; asm volatile("" : "+v"(tid_)); const int tid = tid_, lane = tid & 63; (void)lane
    const int G = gridDim.x, bx = blockIdx.x;
    const int vcu = (G % 8 == 0) ? (bx % 8) * (G / 8) + bx / 8 : bx;
    const int gw = vcu * NWAVES + wave, NGW = G * NWAVES;
    const int NTHR = G * NWAVES * 64;
    unsigned char* ws = args.ws;
    LAS unsigned char* ldsl = (LAS unsigned char*)lds;
    const int lo = args.ph_lo, hi = args.ph_hi;
#ifndef PHASE_MASK
#define PHASE_MASK 0x7ff
#endif
#define IN(k) (((PHASE_MASK >> (k)) & 1) && lo <= (k) && (k) < hi)
#define SEAM(k) do { if (IN(k) && IN((k) + 1)) { asm volatile("s_waitcnt vmcnt(0)" ::: "memory"); __threadfence(); cg::this_grid().sync(); } } while (0)
    const float* x = args.in[0]; float* out = args.out;
    bf16* XB = (bf16*)(ws + WS_XB); bf16* HID = (bf16*)(ws + WS_HID); bf16* QKV = (bf16*)(ws + WS_QKV); bf16* GATES = (bf16*)(ws + WS_GATES);
    float* SS1 = (float*)(ws + WS_SS); float* SS2 = SS1 + M; float* SS3 = SS2 + M;
    float* COS = (float*)(ws + WS_ROPE); float* SIN = COS + (size_t)M * 16;
    float* LSE = (float*)(ws + WS_LSE);
    bf16* ODIFF_RAW = (bf16*)(ws + WS_ODIFF_RAW); bf16* ODIL_RAW = (bf16*)(ws + WS_ODIL_RAW);
    bf16* ODIL = (bf16*)(ws + WS_ODIL); bf16* ODIFF = (bf16*)(ws + WS_ODIFF); bf16* Y = (bf16*)(ws + WS_Y);

    if (IN(0)) {
        PHASE_TID(); const int gtid = bx * (NWAVES * 64) + tid;
        LAS float* scr = (LAS float*)(ldsl + wave * 16384);
        transpose_mat(args.in[3], DM, DFF, args.in[2], (bf16*)(ws + WS_W1GU), 1, scr, gw, NGW, lane);
        transpose_mat(args.in[4], DM, DFF, args.in[2], (bf16*)(ws + WS_W1GU), 2, scr, gw, NGW, lane);
        transpose_mat(args.in[5], DFF, DM, nullptr, (bf16*)(ws + WS_W1D), 0, scr, gw, NGW, lane);
        transpose_mat(args.in[7], DM, DIN, args.in[6], (bf16*)(ws + WS_WIN), 0, scr, gw, NGW, lane);
        transpose_mat(args.in[17], 512, DM, nullptr, (bf16*)(ws + WS_WDIL), 0, scr, gw, NGW, lane);
        transpose_mat(args.in[18], 1024, DM, nullptr, (bf16*)(ws + WS_WDIFF), 0, scr, gw, NGW, lane);
        transpose_mat(args.in[19], DM, DM, nullptr, (bf16*)(ws + WS_WOUT), 0, scr, gw, NGW, lane);
        for (int m = gw; m < M; m += NGW) {
            const f32x4* xr = (const f32x4*)(x + (size_t)m * DM) + lane; f32x4 v[8]; float s = 0.f;
#pragma unroll
            for (int j = 0; j < 8; ++j) { v[j] = xr[64 * j]; s += (v[j].x * v[j].x + v[j].y * v[j].y) + (v[j].z * v[j].z + v[j].w * v[j].w); }
            s = wave_sum(s); if (lane == 0) SS1[m] = s;
            v2u* o8 = (v2u*)(XB + (size_t)m * DM) + lane;
#pragma unroll
            for (int j = 0; j < 8; ++j) { v2u w; w.x = pk2(v[j].x, v[j].y); w.y = pk2(v[j].z, v[j].w); o8[64 * j] = w; }
        }
        for (int i = gtid; i < 2 * M; i += NTHR) SS2[i] = 0.f;
        const int* pos = (const int*)args.in[1];
        for (int idx = gtid; idx < M * 16; idx += NTHR) { const int t = idx >> 4, i = idx & 15;
            const float inv = __builtin_amdgcn_exp2f((float)i * (-1.0f / 16.0f) * 18.931568569324174f);
            const float ang = (float)pos[t] * inv;
            const double rev = (double)ang * 0.15915494309189535; const float fr = (float)(rev - __builtin_rint(rev));
            COS[idx] = __builtin_amdgcn_cosf(fr); SIN[idx] = __builtin_amdgcn_sinf(fr); }
    }
    SEAM(0);
    if (IN(1)) {
        pg8::Gemm g{XB, (bf16*)(ws + WS_W1GU), M, 2 * DFF, DM}; pg8::StaticOrder So; So.init(M, 2 * DFF, G, bx);
        pg8::EpiSwiglu E{HID, DFF, SS1};
        pg8::gemm_phase<pg8::EpiSwiglu, pg8::StaticOrder, true, true>(ldsl, g, So, E);
    }
    SEAM(1);
    if (IN(2)) {
        pg8::Gemm g{HID, (bf16*)(ws + WS_W1D), M, DM, DFF}; pg8::StaticOrder So; So.init(M, DM, G, bx);
        pg8::EpiResid E{x, out, XB, SS2, 0.5f, DM};
        pg8::gemm_phase<pg8::EpiResid, pg8::StaticOrder, true, true>(ldsl, g, So, E);
    }
    SEAM(2);
    if (IN(3)) {
        pg8::Gemm g{XB, (bf16*)(ws + WS_WIN), M, DIN, DM}; pg8::StaticOrder So; So.init(M, DIN, G, bx);
        pg8::EpiScaleSplit E{QKV, NQKV, GATES, NGATE, NQKV / 256, SS2};
        pg8::gemm_phase<pg8::EpiScaleSplit, pg8::StaticOrder, true, true>(ldsl, g, So, E);
    }
    SEAM(3);
    if (IN(4)) {
        PHASE_TID();
        const int sub = lane >> 4, l16 = lane & 15;
        const float* gn_dq = args.in[8]; const float* gn_dk = args.in[9]; const float* gn_fq = args.in[10]; const float* gn_fk = args.in[11];
        for (int it = gw; it < M * 10; it += NGW) {
            const int t = it / 10, jg = it - t * 10, j = jg * 4 + sub;
            const int col = j < 24 ? j * 128 : 4608 + (j - 24) * 128;
            const float* gain = j < 12 ? gn_dq : (j < 24 ? gn_dk : (j < 32 ? gn_fq : gn_fk));
            bf16* p = QKV + (size_t)t * NQKV + col + l16 * 8;
            const v4u w = *(const v4u*)p;
            float v[8] = {bflo(w.x), bfhi(w.x), bflo(w.y), bfhi(w.y), bflo(w.z), bfhi(w.z), bflo(w.w), bfhi(w.w)};
            float s = 0.f;
#pragma unroll
            for (int i = 0; i < 8; ++i) s += v[i] * v[i];
            s += __shfl_xor(s, 1); s += __shfl_xor(s, 2); s += __shfl_xor(s, 4); s += __shfl_xor(s, 8);
            const float rs = rsqrtf(s * (1.0f / 128.0f) + RMS_EPS);
            const f32x4 g0 = *(const f32x4*)(gain + l16 * 8), g1 = *(const f32x4*)(gain + l16 * 8 + 4);
#pragma unroll
            for (int i = 0; i < 4; ++i) { v[i] = v[i] * rs * g0[i]; v[4 + i] = v[4 + i] * rs * g1[i]; }
            const int ci = t * 16 + (l16 & 1) * 8;
            const bool rot = l16 < 4; const float sgn = l16 < 2 ? -1.0f : 1.0f;
#pragma unroll
            for (int i = 0; i < 8; ++i) { const float pr = __shfl_xor(v[i], 2);
                if (rot) { const float c = COS[ci + i], sn = SIN[ci + i]; v[i] = v[i] * c + sgn * pr * sn; } }
            v4u o; o.x = pk2(v[0], v[1]); o.y = pk2(v[2], v[3]); o.z = pk2(v[4], v[5]); o.w = pk2(v[6], v[7]);
            *(v4u*)p = o;
        }
    }
    SEAM(4);
    if (IN(5)) {
        const int w = vcu;
        const int nd = w < 512 ? (512 - w + G - 1) / G : 0, ndl = w < 768 ? (768 - w + G - 1) / G : 0, total = 2 * nd + ndl;
        if (total > 0) {
            att::Seam S;
            { const att::BlockRef c0 = attn_decode(0, w, G, nd, QKV, ODIFF_RAW, ODIL_RAW, LSE); att::attn_prime(c0, (char*)lds, S); }
            for (int s = 0; s < total; ++s) {
                const att::BlockRef cur = attn_decode(s, w, G, nd, QKV, ODIFF_RAW, ODIL_RAW, LSE);
                const att::BlockRef nxt = attn_decode(s + 1 < total ? s + 1 : s, w, G, nd, QKV, ODIFF_RAW, ODIL_RAW, LSE);
                att::attn_block(cur, nxt, (char*)lds, S);
            }
        }
    }
    SEAM(5);
    if (IN(6)) {
        PHASE_TID();
        LAS float* scr = (LAS float*)(ldsl + wave * 16384);
        transpose_mat(args.in[21], DM, DFF, args.in[20], (bf16*)(ws + WS_W2GU), 1, scr, gw, NGW, lane);
        transpose_mat(args.in[22], DM, DFF, args.in[20], (bf16*)(ws + WS_W2GU), 2, scr, gw, NGW, lane);
        transpose_mat(args.in[23], DFF, DM, nullptr, (bf16*)(ws + WS_W2D), 0, scr, gw, NGW, lane);
        float lam;
        { const float a = args.in[12][lane] * args.in[13][lane] + args.in[12][lane + 64] * args.in[13][lane + 64];
          const float b = args.in[14][lane] * args.in[15][lane] + args.in[14][lane + 64] * args.in[15][lane + 64];
          lam = __expf(wave_sum(a)) - __expf(wave_sum(b)) + LAM_INIT; }
        const float* subln = args.in[16];
        for (int t = gw; t < M; t += NGW) {
            {
                const int h = lane >> 4;
                const float l0 = LSE[(size_t)t * 4 + h], l1 = LSE[(size_t)M * 4 + (size_t)t * 4 + h], l2 = LSE[(size_t)M * 8 + (size_t)t * 4 + h];
                const float mx = fmaxf(l0, fmaxf(l1, l2)); const float e0 = __expf(l0 - mx), e1 = __expf(l1 - mx), e2 = __expf(l2 - mx); const float inv = 1.0f / (e0 + e1 + e2);
                const float w0 = e0 * inv, w1 = e1 * inv, w2 = e2 * inv;
                const size_t off = (size_t)t * 512 + lane * 8;
                const v4u a = *(const v4u*)(ODIL_RAW + off), b = *(const v4u*)(ODIL_RAW + (size_t)M * 512 + off), c = *(const v4u*)(ODIL_RAW + (size_t)M * 1024 + off);
                v4u o;
                o.x = pk2(w0 * bflo(a.x) + w1 * bflo(b.x) + w2 * bflo(c.x), w0 * bfhi(a.x) + w1 * bfhi(b.x) + w2 * bfhi(c.x));
                o.y = pk2(w0 * bflo(a.y) + w1 * bflo(b.y) + w2 * bflo(c.y), w0 * bfhi(a.y) + w1 * bfhi(b.y) + w2 * bfhi(c.y));
                o.z = pk2(w0 * bflo(a.z) + w1 * bflo(b.z) + w2 * bflo(c.z), w0 * bfhi(a.z) + w1 * bfhi(b.z) + w2 * bfhi(c.z));
                o.w = pk2(w0 * bflo(a.w) + w1 * bflo(b.w) + w2 * bflo(c.w), w0 * bfhi(a.w) + w1 * bfhi(b.w) + w2 * bfhi(c.w));
                *(v4u*)(ODIL + off) = o;
            }
#pragma unroll
            for (int hh = 0; hh < 2; ++hh) {
                const int l32 = lane & 31;
                const size_t off = (size_t)t * 1024 + (size_t)(hh * 2 + (lane >> 5)) * 256 + l32 * 8;
                const v4u a = *(const v4u*)(ODIFF_RAW + off), b = *(const v4u*)(ODIFF_RAW + (size_t)M * 1024 + off);
                float d[8] = {bflo(a.x) - lam * bflo(b.x), bfhi(a.x) - lam * bfhi(b.x), bflo(a.y) - lam * bflo(b.y), bfhi(a.y) - lam * bfhi(b.y),
                              bflo(a.z) - lam * bflo(b.z), bfhi(a.z) - lam * bfhi(b.z), bflo(a.w) - lam * bflo(b.w), bfhi(a.w) - lam * bfhi(b.w)};
                float s = 0.f;
#pragma unroll
                for (int i = 0; i < 8; ++i) s += d[i] * d[i];
                s += __shfl_xor(s, 1); s += __shfl_xor(s, 2); s += __shfl_xor(s, 4); s += __shfl_xor(s, 8); s += __shfl_xor(s, 16);
                const float rs = rsqrtf(s * (1.0f / 256.0f) + RMS_EPS) * (1.0f - LAM_INIT);
                const f32x4 g0 = *(const f32x4*)(subln + l32 * 8), g1 = *(const f32x4*)(subln + l32 * 8 + 4);
                v4u o; o.x = pk2(d[0] * rs * g0[0], d[1] * rs * g0[1]); o.y = pk2(d[2] * rs * g0[2], d[3] * rs * g0[3]);
                o.z = pk2(d[4] * rs * g1[0], d[5] * rs * g1[1]); o.w = pk2(d[6] * rs * g1[2], d[7] * rs * g1[3]);
                *(v4u*)(ODIFF + off) = o;
            }
        }
    }
    SEAM(6);
    if (IN(7)) {
        { pg8::Gemm g{ODIL, (bf16*)(ws + WS_WDIL), M, DM, 512}; pg8::StaticOrder So; So.init(M, DM, G, bx);
          pg8::EpiGate<false> E{GATES, NGATE, 0, Y, DM};
          pg8::gemm_phase<pg8::EpiGate<false>, pg8::StaticOrder, true, true>(ldsl, g, So, E); }
        asm volatile("s_waitcnt vmcnt(0)" ::: "memory"); __syncthreads();
        { pg8::Gemm g{ODIFF, (bf16*)(ws + WS_WDIFF), M, DM, 1024}; pg8::StaticOrder So; So.init(M, DM, G, bx);
          pg8::EpiGate<true> E{GATES, NGATE, 2048, Y, DM};
          pg8::gemm_phase<pg8::EpiGate<true>, pg8::StaticOrder, true, true>(ldsl, g, So, E); }
    }
    SEAM(7);
    if (IN(8)) {
        pg8::Gemm g{Y, (bf16*)(ws + WS_WOUT), M, DM, DM}; pg8::StaticOrder So; So.init(M, DM, G, bx);
        pg8::EpiResid E{out, out, XB, SS3, 1.0f, DM};
        pg8::gemm_phase<pg8::EpiResid, pg8::StaticOrder, true, true>(ldsl, g, So, E);
    }
    SEAM(8);
    if (IN(9)) {
        pg8::Gemm g{XB, (bf16*)(ws + WS_W2GU), M, 2 * DFF, DM}; pg8::StaticOrder So; So.init(M, 2 * DFF, G, bx);
        pg8::EpiSwiglu E{(bf16*)(ws + WS_HID2), DFF, SS3};
        pg8::gemm_phase<pg8::EpiSwiglu, pg8::StaticOrder, true, true>(ldsl, g, So, E);
    }
    SEAM(9);
    if (IN(10)) {
        pg8::Gemm g{(bf16*)(ws + WS_HID2), (bf16*)(ws + WS_W2D), M, DM, DFF}; pg8::StaticOrder So; So.init(M, DM, G, bx);
        pg8::EpiResid E{out, out, nullptr, nullptr, 0.5f, DM};
        pg8::gemm_phase<pg8::EpiResid, pg8::StaticOrder, true, true>(ldsl, g, So, E);
    }
#undef IN
#undef SEAM
}

extern "C" void kernel_launch(void* const* d_in, const int* in_sizes, int n_in, void* d_out, int out_size, void* d_ws, size_t ws_size, hipStream_t stream) {
    static int grid = 0;
    if (grid == 0) {
        if (n_in != 24 || in_sizes[0] != M * DM || out_size != M * DM || ws_size < WS_END) {
            fprintf(stderr, "kernel_launch: unexpected shapes (n_in %d, in0 %d, out %d, ws %zu, need %zu)\n", n_in, n_in > 0 ? in_sizes[0] : -1, out_size, ws_size, (size_t)WS_END); grid = -1; return; }
        int dev = 0, cus = 0, per_cu = 0;
        if (hipGetDevice(&dev) != hipSuccess || hipDeviceGetAttribute(&cus, hipDeviceAttributeMultiprocessorCount, dev) != hipSuccess) { grid = -1; return; }
        if (hipFuncSetAttribute((const void*)layer_fwd, hipFuncAttributeMaxDynamicSharedMemorySize, LDS_BYTES) != hipSuccess) { fprintf(stderr, "kernel_launch: hipFuncSetAttribute failed\n"); grid = -1; return; }
        if (hipOccupancyMaxActiveBlocksPerMultiprocessor(&per_cu, (const void*)layer_fwd, NWAVES * 64, LDS_BYTES) != hipSuccess || per_cu < 1) { fprintf(stderr, "kernel_launch: occupancy query says %d\n", per_cu); per_cu = 1; }
        (void)hipGetLastError();
        grid = cus * per_cu;
    }
    if (grid < 0) return;
    Args a{};
    for (int i = 0; i < 24; ++i) a.in[i] = (const float*)d_in[i];
    a.out = (float*)d_out; a.ws = (unsigned char*)d_ws;
#if ONE_LAUNCH
    a.ph_lo = 0; a.ph_hi = NPHASE;
    void* kargs[] = {&a};
    hipError_t e = hipLaunchCooperativeKernel((const void*)layer_fwd, dim3(grid), dim3(NWAVES * 64), kargs, LDS_BYTES, stream);
    if (e != hipSuccess) fprintf(stderr, "kernel_launch: cooperative launch failed: %s (grid %d)\n", hipGetErrorString(e), grid);
#else
    for (int p = 0; p < NPHASE; ++p) { a.ph_lo = p; a.ph_hi = p + 1;
        hipLaunchKernelGGL(layer_fwd, dim3(grid), dim3(NWAVES * 64), LDS_BYTES, stream, a); }
#endif
}
```

```cpp
#include <hip/hip_runtime.h>
#include <hip/hip_cooperative_groups.h>
#include <cstdio>
#include <cstdint>
namespace cg = cooperative_groups;
#ifndef ONE_LAUNCH
#define ONE_LAUNCH 1
#endif
namespace pg8 {
#define PG8_LAS __attribute__((address_space(3)))
typedef unsigned short bf16_t;
typedef short bf16x8 __attribute__((ext_vector_type(8)));
typedef float f32x4 __attribute__((ext_vector_type(4)));
typedef unsigned u32x4 __attribute__((ext_vector_type(4)));
constexpr int BM = 256, BK = 64, HALF = 128, HTB = HALF * BK * 2  , STAGE_BYTES = 8 * HTB, NXCD = 8, WGM = 8;

__host__ __device__ __forceinline__ int lds_byte(int r, int c) { const int st = (r >> 4) * 2 + (c >> 5), rr = r & 15, cc = c & 31, ob = rr * 64 + cc * 2; return st * 1024 + (ob ^ (((ob >> 9) & 1) << 5)); }
__host__ __device__ __forceinline__ void stage_rc(int b, int& R, int& C) { const int st = b / 1024, sb = b % 1024, swz = sb ^ (((sb >> 9) & 1) << 5); R = (st >> 1) * 16 + swz / 64; C = (st & 1) * 32 + (swz % 64) / 2; }
__host__ __device__ __forceinline__ int perm32(int rho) { const int n = rho >> 4, i = rho & 15; return 8 * (i >> 2) + 4 * n + (i & 3); }

struct Unit { int pm, pn; };
struct Gemm { const bf16_t* A; const bf16_t* Bt; int M, N, K; };

struct StaticOrder {
    int nM, nN, nwg, G, c;
    __host__ __device__ void init(int M, int N, int G_, int c_) { nM = M / BM; nN = N / BM; nwg = nM * nN; G = G_; c = c_; }
    __host__ __device__ bool next(int i, Unit& u) const {
        const long L = (long)i * G + c; if (L >= nwg) return false;
        int wgid = (int)L; { const int q = nwg / NXCD, r = nwg % NXCD, xcd = wgid % NXCD, off = wgid / NXCD; wgid = (xcd < r ? xcd * (q + 1) : r * (q + 1) + (xcd - r) * q) + off; }
        const int nig = WGM * nN, gid = wgid / nig, fm = gid * WGM, gsz = (nM - fm) < WGM ? (nM - fm) : WGM;
        u.pm = fm + ((wgid % nig) % gsz); u.pn = (wgid % nig) / gsz; return true;
    }
    __device__ __forceinline__ void a_ready(const Unit&) const {}
    __device__ __forceinline__ void done(const Unit&) const {}
};
__device__ __forceinline__ unsigned cvt_pk_bf16(float lo, float hi) { unsigned r; asm volatile("v_cvt_pk_bf16_f32 %0, %1, %2" : "=v"(r) : "v"(lo), "v"(hi)); return r; }
constexpr float RMS_EPS = 1e-6f;
__device__ __forceinline__ float fast_sigmoid(float g) { return __builtin_amdgcn_rcpf(1.0f + __builtin_amdgcn_exp2f(-1.4426950408889634f * g)); }
__device__ __forceinline__ f32x4 bf2f_lo(unsigned a, unsigned b) { f32x4 r; r[0] = __uint_as_float(a << 16); r[1] = __uint_as_float(a & 0xffff0000u); r[2] = __uint_as_float(b << 16); r[3] = __uint_as_float(b & 0xffff0000u); return r; }

struct EpiSwiglu {
    static constexpr bool PERM = true, AFTER_DRAIN = false;
    bf16_t* H; int ldh; const float* ss;
    __device__ __forceinline__ void operator()(const f32x4 (&acc)[2][2][4][2], const Unit& u, int wr, int wc, int fr, int fq) const {
        const int row0 = u.pm * BM + wr * 64 + fr, col0 = u.pn * HALF + wc * 32 + 8 * fq;
#pragma unroll
        for (int ai = 0; ai < 2; ++ai)
#pragma unroll
            for (int m = 0; m < 4; ++m) { const int row = row0 + ai * HALF + m * 16; const float rs = rsqrtf(ss[row] * (1.0f / 2048.0f) + RMS_EPS);
                float h[8];
#pragma unroll
                for (int n = 0; n < 2; ++n)
#pragma unroll
                    for (int j = 0; j < 4; ++j) { const float g = acc[ai][0][m][n][j] * rs, up = acc[ai][1][m][n][j] * rs; h[n * 4 + j] = g * fast_sigmoid(g) * up; }
                u32x4 w; w.x = cvt_pk_bf16(h[0], h[1]); w.y = cvt_pk_bf16(h[2], h[3]); w.z = cvt_pk_bf16(h[4], h[5]); w.w = cvt_pk_bf16(h[6], h[7]);
                *(u32x4*)(H + (size_t)row * ldh + col0) = w; }
    }
};
struct EpiResid {
    static constexpr bool PERM = true, AFTER_DRAIN = false;
    const float* base; float* out; bf16_t* xb; float* ss; float alpha; int ld;
    __device__ __forceinline__ void operator()(const f32x4 (&acc)[2][2][4][2], const Unit& u, int wr, int wc, int fr, int fq) const {
        const int row0 = u.pm * BM + wr * 64 + fr, col0 = u.pn * BM + wc * 32 + 8 * fq;
#pragma unroll
        for (int ai = 0; ai < 2; ++ai)
#pragma unroll
            for (int m = 0; m < 4; ++m) { const int row = row0 + ai * HALF + m * 16; float s = 0.f;
#pragma unroll
                for (int bj = 0; bj < 2; ++bj) { const size_t p = (size_t)row * ld + col0 + bj * HALF;
                    const f32x4 b0 = *(const f32x4*)(base + p), b1 = *(const f32x4*)(base + p + 4);
                    const f32x4 v0 = b0 + acc[ai][bj][m][0] * alpha, v1 = b1 + acc[ai][bj][m][1] * alpha;
                    *(f32x4*)(out + p) = v0; *(f32x4*)(out + p + 4) = v1;
                    if (xb) { u32x4 w; w.x = cvt_pk_bf16(v0[0], v0[1]); w.y = cvt_pk_bf16(v0[2], v0[3]); w.z = cvt_pk_bf16(v1[0], v1[1]); w.w = cvt_pk_bf16(v1[2], v1[3]); *(u32x4*)(xb + p) = w; }
                    s += (v0[0] * v0[0] + v0[1] * v0[1]) + (v0[2] * v0[2] + v0[3] * v0[3]) + (v1[0] * v1[0] + v1[1] * v1[1]) + (v1[2] * v1[2] + v1[3] * v1[3]); }
                if (ss) { s += __shfl_xor(s, 16); s += __shfl_xor(s, 32); if (fq == 0) atomicAdd(ss + row, s); } }
    }
};
struct EpiScaleSplit {
    static constexpr bool PERM = true, AFTER_DRAIN = false;
    bf16_t* O0; int ld0; bf16_t* O1; int ld1; int split_pn; const float* ss;
    __device__ __forceinline__ void operator()(const f32x4 (&acc)[2][2][4][2], const Unit& u, int wr, int wc, int fr, int fq) const {
        const int row0 = u.pm * BM + wr * 64 + fr; const bool first = u.pn < split_pn;
        bf16_t* O = first ? O0 : O1; const int ld = first ? ld0 : ld1; const int col0 = (first ? u.pn : u.pn - split_pn) * BM + wc * 32 + 8 * fq;
#pragma unroll
        for (int ai = 0; ai < 2; ++ai)
#pragma unroll
            for (int m = 0; m < 4; ++m) { const int row = row0 + ai * HALF + m * 16; const float rs = rsqrtf(ss[row] * (1.0f / 2048.0f) + RMS_EPS);
#pragma unroll
                for (int bj = 0; bj < 2; ++bj) { const f32x4 v0 = acc[ai][bj][m][0] * rs, v1 = acc[ai][bj][m][1] * rs;
                    u32x4 w; w.x = cvt_pk_bf16(v0[0], v0[1]); w.y = cvt_pk_bf16(v0[2], v0[3]); w.z = cvt_pk_bf16(v1[0], v1[1]); w.w = cvt_pk_bf16(v1[2], v1[3]);
                    *(u32x4*)(O + (size_t)row * ld + col0 + bj * HALF) = w; } }
    }
};
template <bool ADD> struct EpiGate {
    static constexpr bool PERM = true, AFTER_DRAIN = false;
    const bf16_t* gate; int ldg, goff; bf16_t* Y; int ldy;
    __device__ __forceinline__ void operator()(const f32x4 (&acc)[2][2][4][2], const Unit& u, int wr, int wc, int fr, int fq) const {
        const int row0 = u.pm * BM + wr * 64 + fr, col0 = u.pn * BM + wc * 32 + 8 * fq;
#pragma unroll
        for (int ai = 0; ai < 2; ++ai)
#pragma unroll
            for (int m = 0; m < 4; ++m) { const int row = row0 + ai * HALF + m * 16;
#pragma unroll
                for (int bj = 0; bj < 2; ++bj) { const int col = col0 + bj * HALF;
                    const u32x4 gw = *(const u32x4*)(gate + (size_t)row * ldg + goff + col);
                    const f32x4 g0 = bf2f_lo(gw.x, gw.y), g1 = bf2f_lo(gw.z, gw.w);
                    f32x4 v0, v1;
#pragma unroll
                    for (int j = 0; j < 4; ++j) { v0[j] = fast_sigmoid(g0[j]) * acc[ai][bj][m][0][j]; v1[j] = fast_sigmoid(g1[j]) * acc[ai][bj][m][1][j]; }
                    bf16_t* yp = Y + (size_t)row * ldy + col;
                    if (ADD) { const u32x4 pw = *(const u32x4*)yp; v0 = v0 + bf2f_lo(pw.x, pw.y); v1 = v1 + bf2f_lo(pw.z, pw.w); }
                    u32x4 w; w.x = cvt_pk_bf16(v0[0], v0[1]); w.y = cvt_pk_bf16(v0[2], v0[3]); w.z = cvt_pk_bf16(v1[0], v1[1]); w.w = cvt_pk_bf16(v1[2], v1[3]);
                    *(u32x4*)yp = w; } }
    }
};

template <class Epi, class Sched, bool ALIGN_EPI = false, bool SP2 = false>
__device__ __forceinline__ void gemm_phase(PG8_LAS unsigned char* lds, const Gemm g, const Sched& S, const Epi& E) {
    int tid_ = threadIdx.x; asm volatile("" : "+v"(tid_));
    const int tid = tid_, wid = __builtin_amdgcn_readfirstlane(tid >> 6), lane = tid & 63, wr = wid >> 2, wc = wid & 3, fr = lane & 15, fq = lane >> 4;
    const int K = g.K, nt = K / BK;
    unsigned voffA[2], voffB[2];
#pragma unroll
    for (int i = 0; i < 2; ++i) { int R, C; stage_rc(tid * 16 + i * 8192, R, C); const int Rb = Epi::PERM ? ((R & ~31) + perm32(R & 31)) : R;
        voffA[i] = (unsigned)(R * K + C) * 2u; voffB[i] = (unsigned)(Rb * K + C) * 2u; }
    const size_t kstep = (size_t)(BK * 2);
    const size_t hstep = (size_t)HALF * K * 2;
    const size_t tstep = 2 * hstep;
    const unsigned ldsw = (unsigned)wid * 1024u;
    const int aoff = lds_byte(wr * 64 + fr, fq * 8), boff = lds_byte(wc * 32 + fr, fq * 8);
#define PG8_SA(b, h) (((b) * 2 + (h)) * HTB)
#define PG8_SB(b, h) ((4 + (b) * 2 + (h)) * HTB)
#define PG8_STAGE(bufoff, gbase, voff) do { _Pragma("unroll") for (int _i = 0; _i < 2; ++_i) \
        __builtin_amdgcn_global_load_lds((const unsigned*)((const char*)(gbase) + (voff)[_i]), (PG8_LAS unsigned*)(lds + (bufoff) + ldsw + _i * 8192), 16, 0, 0); } while (0)
#define PG8_LDA(dst, b, h) do { _Pragma("unroll") for (int m = 0; m < 4; ++m) _Pragma("unroll") for (int k = 0; k < 2; ++k) dst[m][k] = *(const PG8_LAS bf16x8*)(lds + PG8_SA(b, h) + aoff + m * 2048 + k * 1024); } while (0)
#define PG8_LDB(dst, b, h) do { _Pragma("unroll") for (int n = 0; n < 2; ++n) _Pragma("unroll") for (int k = 0; k < 2; ++k) dst[n][k] = *(const PG8_LAS bf16x8*)(lds + PG8_SB(b, h) + boff + n * 2048 + k * 1024); } while (0)
#define PG8_MMA(ai, bj, At, Bt) do { __builtin_amdgcn_s_setprio(1); _Pragma("unroll") for (int m = 0; m < 4; ++m) _Pragma("unroll") for (int n = 0; n < 2; ++n) _Pragma("unroll") for (int k = 0; k < 2; ++k) \
        acc[ai][bj][m][n] = __builtin_amdgcn_mfma_f32_16x16x32_bf16(Bt[n][k], At[m][k], acc[ai][bj][m][n], 0, 0, 0); __builtin_amdgcn_s_setprio(0); } while (0)
#define PG8_WAIT_V(n) asm volatile("s_waitcnt vmcnt(" #n ")" ::: "memory")
#define PG8_WAIT_L(n) asm volatile("s_waitcnt lgkmcnt(" #n ")" ::: "memory")
#define PG8_BAR __builtin_amdgcn_s_barrier()
#define PG8_SCHED __builtin_amdgcn_sched_barrier(0)
    Unit cur, nxt; int ui = 0;
    if (!S.next(0, cur)) return;
    f32x4 acc[2][2][4][2];
#pragma unroll
    for (int a = 0; a < 2; ++a)
#pragma unroll
        for (int b = 0; b < 2; ++b)
#pragma unroll
            for (int m = 0; m < 4; ++m)
#pragma unroll
                for (int n = 0; n < 2; ++n) acc[a][b][m][n] = (f32x4){0.f, 0.f, 0.f, 0.f};
    bf16x8 At[4][2], B0[2][2], B1[2][2];
    const char* cA = (const char*)g.A + (size_t)cur.pm * tstep; const char* cB = (const char*)g.Bt + (size_t)cur.pn * tstep;
    S.a_ready(cur);
    if constexpr (SP2) {
        PG8_STAGE(PG8_SB(0, 0), cB, voffB); PG8_STAGE(PG8_SB(0, 1), cB + hstep, voffB); PG8_STAGE(PG8_SA(0, 0), cA, voffA); PG8_STAGE(PG8_SA(0, 1), cA + hstep, voffA);
        if (wr == 1) PG8_BAR;
        PG8_WAIT_V(2); PG8_BAR;
        PG8_STAGE(PG8_SB(1, 0), cB + kstep, voffB); PG8_STAGE(PG8_SA(1, 0), cA + kstep, voffA); PG8_STAGE(PG8_SB(1, 1), cB + hstep + kstep, voffB);
        PG8_WAIT_V(6); PG8_BAR;
    } else {
        PG8_STAGE(PG8_SB(0, 0), cB, voffB); PG8_STAGE(PG8_SA(0, 0), cA, voffA); PG8_STAGE(PG8_SB(0, 1), cB + hstep, voffB); PG8_STAGE(PG8_SA(0, 1), cA + hstep, voffA);
        if (wr == 1) PG8_BAR;
        PG8_WAIT_V(4); PG8_BAR;
        PG8_STAGE(PG8_SB(1, 0), cB + kstep, voffB); PG8_STAGE(PG8_SA(1, 0), cA + kstep, voffA); PG8_STAGE(PG8_SB(1, 1), cB + hstep + kstep, voffB);
        PG8_WAIT_V(6); PG8_BAR;
    }
    for (;;) {
        const bool has_next = S.next(ui + 1, nxt);
        const char* nA = has_next ? (const char*)g.A + (size_t)nxt.pm * tstep : cA; const char* nB = has_next ? (const char*)g.Bt + (size_t)nxt.pn * tstep : cB;
        for (int t = 0; t < nt; t += 2) {
            const bool last = (t == nt - 2);
            const char* a1 = cA + (size_t)(t + 1) * kstep;
            const char* a2 = last ? nA : cA + (size_t)(t + 2) * kstep; const char* b2 = last ? nB : cB + (size_t)(t + 2) * kstep;
            const char* a3 = a2 + kstep; const char* b3 = b2 + kstep;
            if (last && has_next) S.a_ready(nxt);
            if constexpr (SP2) {
            PG8_LDB(B0, 0, 0); PG8_LDB(B1, 0, 1); PG8_SCHED; PG8_LDA(At, 0, 0); PG8_STAGE(PG8_SA(1, 1), a1 + hstep, voffA);
            PG8_WAIT_V(8); PG8_WAIT_L(0); PG8_BAR; PG8_MMA(0, 0, At, B0); PG8_MMA(0, 1, At, B1); PG8_BAR; PG8_SCHED;
            PG8_LDA(At, 0, 1); PG8_STAGE(PG8_SB(0, 0), b2, voffB); PG8_STAGE(PG8_SB(0, 1), b2 + hstep, voffB); PG8_STAGE(PG8_SA(0, 0), a2, voffA);
            PG8_WAIT_V(8); PG8_WAIT_L(0); PG8_BAR; PG8_MMA(1, 0, At, B0); PG8_MMA(1, 1, At, B1); PG8_BAR; PG8_SCHED;
            PG8_LDB(B0, 1, 0); PG8_LDB(B1, 1, 1); PG8_SCHED; PG8_LDA(At, 1, 0); PG8_STAGE(PG8_SA(0, 1), a2 + hstep, voffA);
            PG8_WAIT_V(8); PG8_WAIT_L(0); PG8_BAR; PG8_MMA(0, 0, At, B0); PG8_MMA(0, 1, At, B1); PG8_BAR; PG8_SCHED;
            PG8_LDA(At, 1, 1); PG8_STAGE(PG8_SB(1, 0), b3, voffB); PG8_STAGE(PG8_SB(1, 1), b3 + hstep, voffB); PG8_STAGE(PG8_SA(1, 0), a3, voffA);
            PG8_WAIT_V(8); PG8_WAIT_L(0); PG8_BAR; PG8_MMA(1, 0, At, B0); PG8_MMA(1, 1, At, B1); PG8_BAR; PG8_SCHED;
            } else {
            PG8_LDB(B0, 0, 0); PG8_SCHED; PG8_LDA(At, 0, 0); PG8_STAGE(PG8_SA(1, 1), a1 + hstep, voffA);
            PG8_WAIT_L(8); PG8_BAR; PG8_WAIT_L(0); PG8_MMA(0, 0, At, B0); PG8_BAR; PG8_SCHED;
            PG8_LDB(B1, 0, 1); PG8_STAGE(PG8_SB(0, 0), b2, voffB);
            PG8_BAR; PG8_WAIT_L(0); PG8_MMA(0, 1, At, B1); PG8_BAR;
            PG8_LDA(At, 0, 1); PG8_STAGE(PG8_SA(0, 0), a2, voffA);
            PG8_BAR; PG8_WAIT_L(0); PG8_MMA(1, 0, At, B0); PG8_BAR; PG8_SCHED;
            PG8_STAGE(PG8_SB(0, 1), b2 + hstep, voffB);
            PG8_WAIT_V(6); PG8_BAR; PG8_MMA(1, 1, At, B1); PG8_BAR;
            PG8_LDB(B0, 1, 0); PG8_SCHED; PG8_LDA(At, 1, 0); PG8_STAGE(PG8_SA(0, 1), a2 + hstep, voffA);
            PG8_WAIT_L(8); PG8_BAR; PG8_WAIT_L(0); PG8_MMA(0, 0, At, B0); PG8_BAR; PG8_SCHED;
            PG8_LDB(B1, 1, 1); PG8_STAGE(PG8_SB(1, 0), b3, voffB);
            PG8_BAR; PG8_WAIT_L(0); PG8_MMA(0, 1, At, B1); PG8_BAR;
            PG8_LDA(At, 1, 1); PG8_STAGE(PG8_SA(1, 0), a3, voffA);
            PG8_BAR; PG8_WAIT_L(0); PG8_MMA(1, 0, At, B0); PG8_BAR; PG8_SCHED;
            PG8_STAGE(PG8_SB(1, 1), b3 + hstep, voffB);
            PG8_WAIT_V(6); PG8_BAR; PG8_MMA(1, 1, At, B1); PG8_BAR;
            }
        }
        if constexpr (ALIGN_EPI) { if (wr == 0) PG8_BAR; }
        if constexpr (!Epi::AFTER_DRAIN) { E(acc, cur, wr, wc, fr, fq); S.done(cur); }
        if (!has_next) break;
#pragma unroll
        for (int a = 0; a < 2; ++a)
#pragma unroll
            for (int b = 0; b < 2; ++b)
#pragma unroll
                for (int m = 0; m < 4; ++m)
#pragma unroll
                    for (int n = 0; n < 2; ++n) acc[a][b][m][n] = (f32x4){0.f, 0.f, 0.f, 0.f};
        cur = nxt; cA = nA; cB = nB; ++ui;
        if constexpr (ALIGN_EPI) { if (wr == 1) PG8_BAR; }
    }
    PG8_WAIT_V(0);
    if constexpr (!ALIGN_EPI) { if (wr == 0) PG8_BAR; }
    PG8_BAR;
    if constexpr (Epi::AFTER_DRAIN) { E.fused(acc, cur, wr, wc, fr, fq, lds, wid, lane); S.done(cur); }
#undef PG8_SA
#undef PG8_SB
#undef PG8_STAGE
#undef PG8_LDA
#undef PG8_LDB
#undef PG8_MMA
#undef PG8_WAIT_V
#undef PG8_WAIT_L
#undef PG8_BAR
#undef PG8_SCHED
}
}
namespace att {
typedef unsigned short bf16_t;
typedef short bf16x8 __attribute__((ext_vector_type(8)));
typedef short s16x4 __attribute__((ext_vector_type(4)));
typedef float f32x16 __attribute__((ext_vector_type(16)));
typedef float f32x4 __attribute__((ext_vector_type(4)));
typedef unsigned u32x4 __attribute__((ext_vector_type(4)));
constexpr int D = 128;
constexpr float SCALE = 0.08838834764831845f;
constexpr float THR = 8.f;
constexpr int NW = 8, QBLK = 32, KVBLK = 64, QB = NW * QBLK;
constexpr int SHM_V = KVBLK * D * 2, SHM_K = KVBLK * D * 2;
constexpr int LDS_BYTES = 2 * SHM_V + 2 * SHM_K + NW * 64 * 4;

#define KSWZ(row, colB) ((row) * 256 + ((colB) ^ (((row) & 7) << 4)))
#define SBAR() __builtin_amdgcn_sched_barrier(0)
__device__ __forceinline__ int v_st(int k, int c) { const int kk = (k & ~0xC) | ((k & 4) << 1) | ((k & 8) >> 1); return ((kk >> 3) * 4 + (c >> 5)) * 512 + ((kk & 7) * 32 + (c & 31)) * 2; }
__device__ __forceinline__ int v_rd_base(int lane) { return ((lane & 3) << 3) | (((lane >> 2) & 3) << 6) | (((lane >> 4) & 1) << 5) | (((lane >> 5) & 1) << 8); }
constexpr int v_rd_off(int d0, int ks, int half) { return d0 * 512 + ks * 4096 + half * 2048; }
__device__ __forceinline__ int crow(int r, int hi) { return (r & 3) + 8 * (r >> 2) + 4 * hi; }
__device__ __forceinline__ unsigned cvtpk(float lo, float hi) { unsigned r; asm volatile("v_cvt_pk_bf16_f32 %0, %1, %2" : "=v"(r) : "v"(lo), "v"(hi)); return r; }
__device__ __forceinline__ bf16x8 ld8(const bf16_t* p) { return *reinterpret_cast<const bf16x8*>(p); }
__device__ __forceinline__ void mask_tile(f32x16& p0, f32x16& p1, int dq, unsigned W) {
    const float NEG = -__builtin_inff();
#pragma unroll
    for (int r = 0; r < 16; ++r) {
        const int c = (r & 3) + 8 * (r >> 2);
        if ((unsigned)(dq - c) >= W) p0[r] = NEG;
        if ((unsigned)(dq - c - 32) >= W) p1[r] = NEG;
    }
}
__device__ __forceinline__ void partialSM(f32x16& p0, f32x16& p1, float& m_reg, float& mn, float& alpha) {
    float pmax = p0[0]; for (int r = 1; r < 16; ++r) pmax = fmaxf(pmax, p0[r]); for (int r = 0; r < 16; ++r) pmax = fmaxf(pmax, p1[r]);
    { auto rr = __builtin_amdgcn_permlane32_swap(__float_as_uint(pmax), __float_as_uint(pmax), false, false);
      pmax = fmaxf(__uint_as_float(rr[0]), __uint_as_float(rr[1])); }
    constexpr float C2 = 1.4426950408889634f * SCALE;
    if (__builtin_expect(__all((pmax - m_reg) * SCALE <= THR), 1)) { mn = m_reg; alpha = 1.f; }
    else { mn = fmaxf(m_reg, pmax); alpha = __builtin_amdgcn_exp2f((m_reg - mn) * C2); m_reg = mn; }
    const float mnL = -mn * C2;
    for (int r = 0; r < 16; ++r) p0[r] = fmaf(p0[r], C2, mnL); for (int r = 0; r < 16; ++r) p1[r] = fmaf(p1[r], C2, mnL);
    for (int r = 0; r < 16; ++r) p0[r] = __builtin_amdgcn_exp2f(p0[r]);
}
__device__ __forceinline__ void finishSM(f32x16& p0, f32x16& p1, float alpha, float& l_reg, bf16x8& pa0, bf16x8& pa1, bf16x8& pa2, bf16x8& pa3) {
    for (int r = 0; r < 16; ++r) p1[r] = __builtin_amdgcn_exp2f(p1[r]);
    float ps = 0; for (int r = 0; r < 16; ++r) ps += p0[r]; for (int r = 0; r < 16; ++r) ps += p1[r];
    { auto rr = __builtin_amdgcn_permlane32_swap(__float_as_uint(ps), __float_as_uint(ps), false, false);
      ps = __uint_as_float(rr[0]) + __uint_as_float(rr[1]); }
    l_reg = l_reg * alpha + ps;
#define PK4(P, B_, OUT) do { unsigned a0 = cvtpk(P[B_+0], P[B_+1]), a1 = cvtpk(P[B_+2], P[B_+3]);                          \
        unsigned b0 = cvtpk(P[B_+4], P[B_+5]), b1 = cvtpk(P[B_+6], P[B_+7]);                                             \
        auto r0 = __builtin_amdgcn_permlane32_swap(a0, b0, false, false); auto r1 = __builtin_amdgcn_permlane32_swap(a1, b1, false, false); \
        u32x4 w = {r0[0], r1[0], r0[1], r1[1]}; OUT = *reinterpret_cast<bf16x8*>(&w); } while (0)
    PK4(p0, 0, pa0); PK4(p0, 8, pa1); PK4(p1, 0, pa2); PK4(p1, 8, pa3);
#undef PK4
}
template <int KB>
__device__ __forceinline__ void qkt(f32x16& p0, f32x16& p1, const char* K_lds, int r32, int hi, const bf16x8* qr) {
    p0 = f32x16{}; p1 = f32x16{};
    const char* kb[4];
#pragma unroll
    for (int dd = 0; dd < 4; ++dd) kb[dd] = K_lds + KB * SHM_K + KSWZ(r32, (dd * 16 + hi * 8) * 2);
#pragma unroll
    for (int d0 = 0; d0 < 8; ++d0) { const char* a = kb[d0 & 3] + (d0 >> 2) * 128;
        bf16x8 b0 = *reinterpret_cast<const bf16x8*>(a);
        bf16x8 b1 = *reinterpret_cast<const bf16x8*>(a + 32 * 256);
        p0 = __builtin_amdgcn_mfma_f32_32x32x16_bf16(b0, qr[d0], p0, 0, 0, 0);
        p1 = __builtin_amdgcn_mfma_f32_32x32x16_bf16(b1, qr[d0], p1, 0, 0, 0); }
}
template <int VB>
__device__ __forceinline__ void pv_tile(f32x16* o, int vb0, bf16x8 pa0, bf16x8 pa1, bf16x8 pa2, bf16x8 pa3) {
#define TRRD(dst, off) asm volatile("ds_read_b64_tr_b16 %0, %1 offset:%2" : "=&v"(dst) : "v"(vb0), "i"(off) : "memory")
#define PV_D0(d0) do { s16x4 l0, l1, l2, l3, h0, h1, h2, h3; constexpr int b_ = VB * SHM_V + v_rd_off(d0, 0, 0);   \
        TRRD(l0, b_); TRRD(h0, b_ + 2048); TRRD(l1, b_ + 4096); TRRD(h1, b_ + 6144); TRRD(l2, b_ + 8192); TRRD(h2, b_ + 10240); TRRD(l3, b_ + 12288); TRRD(h3, b_ + 14336); \
        asm volatile("s_waitcnt lgkmcnt(0)" ::: "memory"); SBAR();   \
        o[d0] = __builtin_amdgcn_mfma_f32_32x32x16_bf16(pa0, (bf16x8){l0[0], l0[1], l0[2], l0[3], h0[0], h0[1], h0[2], h0[3]}, o[d0], 0, 0, 0);   \
        o[d0] = __builtin_amdgcn_mfma_f32_32x32x16_bf16(pa1, (bf16x8){l1[0], l1[1], l1[2], l1[3], h1[0], h1[1], h1[2], h1[3]}, o[d0], 0, 0, 0);   \
        o[d0] = __builtin_amdgcn_mfma_f32_32x32x16_bf16(pa2, (bf16x8){l2[0], l2[1], l2[2], l2[3], h2[0], h2[1], h2[2], h2[3]}, o[d0], 0, 0, 0);   \
        o[d0] = __builtin_amdgcn_mfma_f32_32x32x16_bf16(pa3, (bf16x8){l3[0], l3[1], l3[2], l3[3], h3[0], h3[1], h3[2], h3[3]}, o[d0], 0, 0, 0); } while (0)
    PV_D0(0); PV_D0(1); PV_D0(2); PV_D0(3);
#undef PV_D0
#undef TRRD
}

struct BlockRef { const bf16_t* Q; const bf16_t* K; const bf16_t* V; bf16_t* O; float* LSE; int rs, os, ls, P0, W, skv; };
struct Seam { bf16x8 qr[8]; bf16x8 st_v0, st_v1, st_k0, st_k1; };
__device__ __forceinline__ int swa_jlo(int P0, int W) { const int lowk = P0 - W + 1; return lowk > 0 ? lowk / KVBLK : 0; }
#define VMW() asm volatile("s_waitcnt vmcnt(0)" ::: "memory")
#define VMWN(n) asm volatile("s_waitcnt vmcnt(%0)" :: "i"(n) : "memory")
#define SLOAD_H(Kp, Vp, RS, k0) do { const bf16_t* kq_ = (Kp) + (size_t)(k0) * (RS); const bf16_t* vq_ = (Vp) + (size_t)(k0) * (RS); const int o0_ = sr * (RS) + sc, o1_ = (32 + sr) * (RS) + sc; \
                         S.st_v0 = ld8(vq_ + o0_); S.st_v1 = ld8(vq_ + o1_); S.st_k0 = ld8(kq_ + o0_); S.st_k1 = ld8(kq_ + o1_); } while (0)
#define SWRITE_HK(bf) do { *(bf16x8*)(K_lds + (bf) * SHM_K + kws) = S.st_k0; *(bf16x8*)(K_lds + (bf) * SHM_K + kws + 32 * 256) = S.st_k1; } while (0)
#define SWRITE_HV(bf) do { *(bf16x8*)(V_lds + (bf) * SHM_V + vst0) = S.st_v0; *(bf16x8*)(V_lds + (bf) * SHM_V + vst1) = S.st_v1; } while (0)
#define SWRITE_H(bf) do { SWRITE_HV(bf); SWRITE_HK(bf); } while (0)
__device__ __forceinline__ void attn_prime(const BlockRef& cur, char* lds, Seam& S) {
    int tid_ = threadIdx.x; asm volatile("" : "+v"(tid_));
    const int tid = tid_, wid = __builtin_amdgcn_readfirstlane(tid >> 6), lane = tid & 63, r32 = lane & 31, hi = lane >> 5;
    const int sr = tid >> 4, sc = (tid & 15) * 8, kws = KSWZ(sr, sc * 2); char* K_lds = lds + 2 * SHM_V;
    const int kb0 = swa_jlo(cur.P0, cur.W) * KVBLK;
    for (int d0 = 0; d0 < 8; ++d0) S.qr[d0] = ld8(cur.Q + (size_t)(wid * QBLK + r32) * cur.rs + d0 * 16 + hi * 8);
    SLOAD_H(cur.K, cur.V, cur.rs, kb0); VMW(); SWRITE_HK(0);
    __syncthreads();
}
__device__ __forceinline__ void attn_block(const BlockRef& cur, const BlockRef& nxt, char* lds, Seam& S) {
    int tid_ = threadIdx.x; asm volatile("" : "+v"(tid_));
    const int tid = tid_, wid = __builtin_amdgcn_readfirstlane(tid >> 6), lane = tid & 63, r32 = lane & 31, hi = lane >> 5;
    const int W = cur.W, skv = cur.skv, RS = cur.rs;
    const int j_lo = swa_jlo(cur.P0, W);
    int j_hi = (cur.P0 + QB - 1) / KVBLK + 1; if (j_hi > skv / KVBLK) j_hi = skv / KVBLK;
    const int NT = j_hi - j_lo;
    const int kbn = swa_jlo(nxt.P0, nxt.W) * KVBLK;
    const int qlo = cur.P0 + wid * QBLK, qm = qlo + r32 - 4 * hi;
    char* V_lds = lds; char* K_lds = lds + 2 * SHM_V;
    float* ws = (float*)(lds + 2 * SHM_V + 2 * SHM_K) + wid * 64; float* li_l = ws, * al_l = ws + 32;
    float m_reg = -1e30f, l_reg = 0; f32x16 o[4] = {};
    const int sr = tid >> 4, sc = (tid & 15) * 8, vst0 = v_st(sr, sc), vst1 = v_st(32 + sr, sc), kws = KSWZ(sr, sc * 2);
    const int vb0 = (int)(uintptr_t)V_lds + v_rd_base(lane);
    const bf16_t* Kh = cur.K; const bf16_t* Vh = cur.V;
#define RESC(a) do { if (__any((a) < 1.f)) { if (hi == 0) al_l[r32] = (a); asm volatile("s_waitcnt lgkmcnt(0)" ::: "memory");              \
                     for (int d_ = 0; d_ < 4; ++d_) for (int r = 0; r < 16; ++r) o[d_][r] *= al_l[crow(r, hi)]; } } while (0)
#define KBASE(t) ((j_lo + (t)) * KVBLK)
#define MASKT(P0_, P1_, t) do { const int kb_ = KBASE(t); if (kb_ + KVBLK - 1 > qlo || kb_ <= qlo + QBLK - 1 - W) mask_tile(P0_, P1_, qm - kb_, (unsigned)W); } while (0)
    constexpr int NQL = 8;
#define SEAM_K0() do { VMWN(NQL); SWRITE_HK(0); SBAR(); } while (0)
    f32x16 pA0, pA1, pB0, pB1; float mnA, mnB, alA, alB; bf16x8 pa0, pa1, pa2, pa3;
    SWRITE_HV(0); SBAR();
    if (NT > 1) { SLOAD_H(Kh, Vh, RS, KBASE(1)); }
    SBAR(); qkt<0>(pA0, pA1, K_lds, r32, hi, S.qr);
    MASKT(pA0, pA1, 0); partialSM(pA0, pA1, m_reg, mnA, alA);
    if (NT > 1) { VMW(); SWRITE_H(1); }
    __syncthreads();
#define HALF_STEP(PX0, PX1, mnX, alX, PY0, PY1, alY, t, KB, VB, SB) do {                                                      \
        SBAR(); qkt<KB>(PX0, PX1, K_lds, r32, hi, S.qr);                                                                      \
        finishSM(PY0, PY1, alY, l_reg, pa0, pa1, pa2, pa3); SBAR();                                                           \
        if ((t) + 1 < NT) { SLOAD_H(Kh, Vh, RS, KBASE((t) + 1)); SBAR(); }                                                    \
        pv_tile<VB>(o, vb0, pa0, pa1, pa2, pa3); MASKT(PX0, PX1, (t)); partialSM(PX0, PX1, m_reg, mnX, alX);                  \
        __syncthreads();                                                                                                      \
        if ((t) + 1 < NT) { VMW(); SWRITE_H(SB); }                                                                            \
        RESC(alX); __syncthreads(); } while (0)
    for (int t = 1; t + 1 < NT; t += 2) {
        HALF_STEP(pB0, pB1, mnB, alB, pA0, pA1, alA, t, 1, 0, 0);
        HALF_STEP(pA0, pA1, mnA, alA, pB0, pB1, alB, t + 1, 0, 1, 1);
    }
    const bool even = (NT & 1) == 0;
    if (even) { SBAR(); qkt<1>(pB0, pB1, K_lds, r32, hi, S.qr); SBAR(); }
    SLOAD_H(nxt.K, nxt.V, nxt.rs, kbn); SBAR();
#pragma unroll
    for (int d0 = 0; d0 < 8; ++d0) S.qr[d0] = ld8(nxt.Q + (size_t)(wid * QBLK + r32) * nxt.rs + d0 * 16 + hi * 8);
    SBAR();
    finishSM(pA0, pA1, alA, l_reg, pa0, pa1, pa2, pa3); SBAR();
    pv_tile<0>(o, vb0, pa0, pa1, pa2, pa3);
    if (even) { MASKT(pB0, pB1, NT - 1); partialSM(pB0, pB1, m_reg, mnB, alB); __syncthreads(); RESC(alB);
        finishSM(pB0, pB1, alB, l_reg, pa0, pa1, pa2, pa3); SBAR(); pv_tile<1>(o, vb0, pa0, pa1, pa2, pa3); }
    SBAR(); SEAM_K0();
    if (hi == 0) li_l[r32] = l_reg; asm volatile("s_waitcnt lgkmcnt(0)" ::: "memory");
    if (cur.LSE && hi == 0) cur.LSE[(size_t)(wid * QBLK + r32) * cur.ls] = m_reg * SCALE + __logf(l_reg);
    float rli[16];
#pragma unroll
    for (int r = 0; r < 16; ++r) rli[r] = __builtin_amdgcn_rcpf(li_l[crow(r, hi)]);
    bf16_t* Ow = cur.O + (size_t)(wid * QBLK) * cur.os;
#pragma unroll
    for (int r = 0; r < 16; ++r) { const int orow = crow(r, hi);
#pragma unroll
        for (int d0 = 0; d0 < 4; ++d0) { const float v = o[d0][r] * rli[r];
            const float vn = __shfl_xor(v, 1);
            if ((r32 & 1) == 0) *(unsigned*)(Ow + (size_t)orow * cur.os + d0 * 32 + r32) = cvtpk(v, vn); } }
    __syncthreads();
#undef RESC
#undef KBASE
#undef MASKT
#undef SEAM_K0
#undef HALF_STEP
}
#undef VMW
#undef VMWN
#undef SLOAD_H
#undef SWRITE_HK
#undef SWRITE_HV
#undef SWRITE_H
}

#define GAS __attribute__((address_space(1)))
#define LAS __attribute__((address_space(3)))
typedef unsigned short bf16;
typedef unsigned v4u __attribute__((ext_vector_type(4)));
typedef unsigned v2u __attribute__((ext_vector_type(2)));
typedef float f32x4 __attribute__((ext_vector_type(4)));
#define LDS_WAIT() asm volatile("s_waitcnt lgkmcnt(0)" ::: "memory")
__device__ __forceinline__ unsigned f2bf(float f) { unsigned u = __builtin_bit_cast(unsigned, f); return (u + 0x7fffu + ((u >> 16) & 1u)) >> 16; }
__device__ __forceinline__ unsigned pk2(float lo, float hi) { return f2bf(lo) | (f2bf(hi) << 16); }
__device__ __forceinline__ float bflo(unsigned w) { return __uint_as_float(w << 16); }
__device__ __forceinline__ float bfhi(unsigned w) { return __uint_as_float(w & 0xffff0000u); }

constexpr int NB = 4, SEQ = 4096, DM = 2048, M = NB * SEQ, DFF = 5632, NQKV = 7680, NGATE = 4096, DIN = NQKV + NGATE;
constexpr int NWAVES = 8;
constexpr float RMS_EPS = 1e-6f;
constexpr float LAM_INIT = 0.2f;
constexpr size_t MiB = 1u << 20;
constexpr size_t WS_QKV = 0, WS_GATES = 240 * MiB;
constexpr size_t WS_W1GU = 0, WS_W1D = 44 * MiB, WS_HID = 66 * MiB;
constexpr size_t WS_XB = 368 * MiB;
constexpr size_t WS_ODIFF_RAW = 368 * MiB;
constexpr size_t WS_WIN = 432 * MiB;
constexpr size_t WS_ODIL_RAW = 432 * MiB;
constexpr size_t WS_LSE = 480 * MiB;
constexpr size_t WS_SS = 481 * MiB;
constexpr size_t WS_ROPE = 482 * MiB;
constexpr size_t WS_WOUT = 484 * MiB, WS_WDIL = 492 * MiB, WS_WDIFF = 494 * MiB;
constexpr size_t WS_W2GU = 0, WS_W2D = 44 * MiB, WS_ODIL = 66 * MiB, WS_ODIFF = 82 * MiB, WS_Y = 114 * MiB;
constexpr size_t WS_HID2 = 66 * MiB;
constexpr size_t WS_END = 498 * MiB;
constexpr int LDS_BYTES = 133120;

__device__ __forceinline__ float wave_sum(float v) {
#pragma unroll
    for (int o = 1; o < 64; o <<= 1) v += __shfl_xor(v, o);
    return v;
}
__device__ __forceinline__ void transpose_item(const float* W, int K, int N, const float* gain, bf16* WT, int mode, LAS float* scr, int item, int lane) {
    const int nblk = N / 32, kb = item / nblk, nb = item % nblk, k0 = 64 * kb, n0 = 32 * nb;
#pragma unroll 8
    for (int i = 0; i < 32; ++i) { const int kk = 2 * i + (lane >> 5); const float g = gain ? gain[k0 + kk] : 1.0f; scr[kk * 33 + (lane & 31)] = W[(size_t)(k0 + kk) * N + n0 + (lane & 31)] * g; }
    LDS_WAIT(); asm volatile("" ::: "memory");
    const int c = lane & 7;
    const int rbase = mode == 0 ? n0 : ((n0 >> 7) * 256 + (mode == 2 ? 128 : 0) + (n0 & 127));
#pragma unroll
    for (int j = 0; j < 4; ++j) { const int n = (lane >> 3) + 8 * j; const LAS float* s = scr + (8 * c) * 33 + n;
        v4u o; o.x = pk2(s[0 * 33], s[1 * 33]); o.y = pk2(s[2 * 33], s[3 * 33]); o.z = pk2(s[4 * 33], s[5 * 33]); o.w = pk2(s[6 * 33], s[7 * 33]);
        *(v4u*)(WT + (size_t)(rbase + n) * K + k0 + 8 * c) = o; }
    LDS_WAIT(); asm volatile("" ::: "memory");
}
__device__ __forceinline__ void transpose_mat(const float* W, int K, int N, const float* gain, bf16* WT, int mode, LAS float* scr, int gw, int NGW, int lane) {
    const int nit = (K / 64) * (N / 32);
    for (int it = gw; it < nit; it += NGW) transpose_item(W, K, N, gain, WT, mode, scr, it, lane);
}

struct Args { const float* in[24]; float* out; unsigned char* ws; int ph_lo, ph_hi; };
constexpr int NPHASE = 11;

__device__ __forceinline__ att::BlockRef attn_decode(int s, int w, int G, int nd, bf16* qkv, bf16* odiff_raw, bf16* odil_raw, float* lse) {
    att::BlockRef r;
    if (s < 2 * nd) {
        const int item = w + (s >> 1) * G, pass = s & 1, head = item >> 3, y = item & 7, qb = pass ? 15 - y : y;
        const int vh = head & 1, comp = (head >> 1) & 1, h = (head >> 2) & 3, b = head >> 4;
        bf16* base = qkv + (size_t)(b * SEQ) * NQKV;
        r.Q = base + 4608 + h * 256 + comp * 128 + (size_t)(qb * 256) * NQKV;
        r.K = base + 5632 + h * 256 + comp * 128;
        r.V = base + 6656 + h * 256 + vh * 128;
        r.O = odiff_raw + (size_t)comp * ((size_t)M * 1024) + (size_t)(b * SEQ + qb * 256) * 1024 + h * 256 + vh * 128;
        r.LSE = nullptr; r.rs = NQKV; r.os = 1024; r.ls = 0; r.P0 = qb * 256; r.W = 1 << 30; r.skv = SEQ;
    } else {
        const int blk = w + (s - 2 * nd) * G, g = blk >> 8, rem = blk & 255;
        const int dil = g == 0 ? 1 : (g == 1 ? 4 : 16), L = SEQ / dil, nqb = L / 256;
        const int qb = rem % nqb; int t = rem / nqb; const int c = t % dil; t /= dil; const int h = t & 3, b = t >> 2;
        const size_t tok0 = (size_t)b * SEQ + c;
        bf16* base = qkv + tok0 * NQKV + g * 512 + h * 128;
        r.Q = base + (size_t)(qb * 256) * ((size_t)dil * NQKV);
        r.K = base + 1536;
        r.V = base + 3072;
        r.O = odil_raw + (size_t)g * ((size_t)M * 512) + tok0 * 512 + h * 128 + (size_t)(qb * 256) * ((size_t)dil * 512);
        r.LSE = lse + (size_t)g * ((size_t)M * 4) + tok0 * 4 + h + (size_t)(qb * 256) * ((size_t)dil * 4);
        r.rs = dil * NQKV; r.os = dil * 512; r.ls = dil * 4; r.P0 = qb * 256; r.W = 129; r.skv = L;
    }
    return r;
}

__global__ void __launch_bounds__(NWAVES * 64, 2) layer_fwd(Args args) {
    extern __shared__ __attribute__((aligned(16))) unsigned char lds[];
    const int wave = __builtin_amdgcn_readfirstlane((int)threadIdx.x >> 6);
#define PHASE_TID() int tid_ = threadIdx.x; asm volatile("" : "+v"(tid_)); const int tid = tid_, lane = tid & 63; (void)lane
    const int G = gridDim.x, bx = blockIdx.x;
    const int vcu = (G % 8 == 0) ? (bx % 8) * (G / 8) + bx / 8 : bx;
    const int gw = vcu * NWAVES + wave, NGW = G * NWAVES;
    const int NTHR = G * NWAVES * 64;
    unsigned char* ws = args.ws;
    LAS unsigned char* ldsl = (LAS unsigned char*)lds;
    const int lo = args.ph_lo, hi = args.ph_hi;
#ifndef PHASE_MASK
#define PHASE_MASK 0x7ff
#endif
#define IN(k) (((PHASE_MASK >> (k)) & 1) && lo <= (k) && (k) < hi)
#define SEAM(k) do { if (IN(k) && IN((k) + 1)) { asm volatile("s_waitcnt vmcnt(0)" ::: "memory"); cg::this_grid().sync(); } } while (0)
    const float* x = args.in[0]; float* out = args.out;
    bf16* XB = (bf16*)(ws + WS_XB); bf16* HID = (bf16*)(ws + WS_HID); bf16* QKV = (bf16*)(ws + WS_QKV); bf16* GATES = (bf16*)(ws + WS_GATES);
    float* SS1 = (float*)(ws + WS_SS); float* SS2 = SS1 + M; float* SS3 = SS2 + M;
    float* COS = (float*)(ws + WS_ROPE); float* SIN = COS + (size_t)M * 16;
    float* LSE = (float*)(ws + WS_LSE);
    bf16* ODIFF_RAW = (bf16*)(ws + WS_ODIFF_RAW); bf16* ODIL_RAW = (bf16*)(ws + WS_ODIL_RAW);
    bf16* ODIL = (bf16*)(ws + WS_ODIL); bf16* ODIFF = (bf16*)(ws + WS_ODIFF); bf16* Y = (bf16*)(ws + WS_Y);

    if (IN(0)) {
        PHASE_TID(); const int gtid = bx * (NWAVES * 64) + tid;
        LAS float* scr = (LAS float*)(ldsl + wave * 16384);
        transpose_mat(args.in[3], DM, DFF, args.in[2], (bf16*)(ws + WS_W1GU), 1, scr, gw, NGW, lane);
        transpose_mat(args.in[4], DM, DFF, args.in[2], (bf16*)(ws + WS_W1GU), 2, scr, gw, NGW, lane);
        transpose_mat(args.in[5], DFF, DM, nullptr, (bf16*)(ws + WS_W1D), 0, scr, gw, NGW, lane);
        transpose_mat(args.in[7], DM, DIN, args.in[6], (bf16*)(ws + WS_WIN), 0, scr, gw, NGW, lane);
        transpose_mat(args.in[17], 512, DM, nullptr, (bf16*)(ws + WS_WDIL), 0, scr, gw, NGW, lane);
        transpose_mat(args.in[18], 1024, DM, nullptr, (bf16*)(ws + WS_WDIFF), 0, scr, gw, NGW, lane);
        transpose_mat(args.in[19], DM, DM, nullptr, (bf16*)(ws + WS_WOUT), 0, scr, gw, NGW, lane);
        for (int m = gw; m < M; m += NGW) {
            const f32x4* xr = (const f32x4*)(x + (size_t)m * DM) + lane; f32x4 v[8]; float s = 0.f;
#pragma unroll
            for (int j = 0; j < 8; ++j) { v[j] = xr[64 * j]; s += (v[j].x * v[j].x + v[j].y * v[j].y) + (v[j].z * v[j].z + v[j].w * v[j].w); }
            s = wave_sum(s); if (lane == 0) SS1[m] = s;
            v2u* o8 = (v2u*)(XB + (size_t)m * DM) + lane;
#pragma unroll
            for (int j = 0; j < 8; ++j) { v2u w; w.x = pk2(v[j].x, v[j].y); w.y = pk2(v[j].z, v[j].w); o8[64 * j] = w; }
        }
        for (int i = gtid; i < 2 * M; i += NTHR) SS2[i] = 0.f;
        const int* pos = (const int*)args.in[1];
        for (int idx = gtid; idx < M * 16; idx += NTHR) { const int t = idx >> 4, i = idx & 15;
            const float inv = __builtin_amdgcn_exp2f((float)i * (-1.0f / 16.0f) * 18.931568569324174f);
            const float ang = (float)pos[t] * inv;
            const double rev = (double)ang * 0.15915494309189535; const float fr = (float)(rev - __builtin_rint(rev));
            COS[idx] = __builtin_amdgcn_cosf(fr); SIN[idx] = __builtin_amdgcn_sinf(fr); }
    }
    SEAM(0);
    if (IN(1)) {
        pg8::Gemm g{XB, (bf16*)(ws + WS_W1GU), M, 2 * DFF, DM}; pg8::StaticOrder So; So.init(M, 2 * DFF, G, bx);
        pg8::EpiSwiglu E{HID, DFF, SS1};
        pg8::gemm_phase<pg8::EpiSwiglu, pg8::StaticOrder, true, true>(ldsl, g, So, E);
    }
    SEAM(1);
    if (IN(2)) {
        pg8::Gemm g{HID, (bf16*)(ws + WS_W1D), M, DM, DFF}; pg8::StaticOrder So; So.init(M, DM, G, bx);
        pg8::EpiResid E{x, out, XB, SS2, 0.5f, DM};
        pg8::gemm_phase<pg8::EpiResid, pg8::StaticOrder, true, true>(ldsl, g, So, E);
    }
    SEAM(2);
    if (IN(3)) {
        pg8::Gemm g{XB, (bf16*)(ws + WS_WIN), M, DIN, DM}; pg8::StaticOrder So; So.init(M, DIN, G, bx);
        pg8::EpiScaleSplit E{QKV, NQKV, GATES, NGATE, NQKV / 256, SS2};
        pg8::gemm_phase<pg8::EpiScaleSplit, pg8::StaticOrder, true, true>(ldsl, g, So, E);
    }
    SEAM(3);
    if (IN(4)) {
        PHASE_TID();
        const int sub = lane >> 4, l16 = lane & 15;
        const float* gn_dq = args.in[8]; const float* gn_dk = args.in[9]; const float* gn_fq = args.in[10]; const float* gn_fk = args.in[11];
        for (int it = gw; it < M * 10; it += NGW) {
            const int t = it / 10, jg = it - t * 10, j = jg * 4 + sub;
            const int col = j < 24 ? j * 128 : 4608 + (j - 24) * 128;
            const float* gain = j < 12 ? gn_dq : (j < 24 ? gn_dk : (j < 32 ? gn_fq : gn_fk));
            bf16* p = QKV + (size_t)t * NQKV + col + l16 * 8;
            const v4u w = *(const v4u*)p;
            float v[8] = {bflo(w.x), bfhi(w.x), bflo(w.y), bfhi(w.y), bflo(w.z), bfhi(w.z), bflo(w.w), bfhi(w.w)};
            float s = 0.f;
#pragma unroll
            for (int i = 0; i < 8; ++i) s += v[i] * v[i];
            s += __shfl_xor(s, 1); s += __shfl_xor(s, 2); s += __shfl_xor(s, 4); s += __shfl_xor(s, 8);
            const float rs = rsqrtf(s * (1.0f / 128.0f) + RMS_EPS);
            const f32x4 g0 = *(const f32x4*)(gain + l16 * 8), g1 = *(const f32x4*)(gain + l16 * 8 + 4);
#pragma unroll
            for (int i = 0; i < 4; ++i) { v[i] = v[i] * rs * g0[i]; v[4 + i] = v[4 + i] * rs * g1[i]; }
            const int ci = t * 16 + (l16 & 1) * 8;
            const bool rot = l16 < 4; const float sgn = l16 < 2 ? -1.0f : 1.0f;
#pragma unroll
            for (int i = 0; i < 8; ++i) { const float pr = __shfl_xor(v[i], 2);
                if (rot) { const float c = COS[ci + i], sn = SIN[ci + i]; v[i] = v[i] * c + sgn * pr * sn; } }
            v4u o; o.x = pk2(v[0], v[1]); o.y = pk2(v[2], v[3]); o.z = pk2(v[4], v[5]); o.w = pk2(v[6], v[7]);
            *(v4u*)p = o;
        }
    }
    SEAM(4);
    if (IN(5)) {
        const int w = vcu;
        const int nd = w < 512 ? (512 - w + G - 1) / G : 0, ndl = w < 768 ? (768 - w + G - 1) / G : 0, total = 2 * nd + ndl;
        if (total > 0) {
            att::Seam S;
            { const att::BlockRef c0 = attn_decode(0, w, G, nd, QKV, ODIFF_RAW, ODIL_RAW, LSE); att::attn_prime(c0, (char*)lds, S); }
            for (int s = 0; s < total; ++s) {
                const att::BlockRef cur = attn_decode(s, w, G, nd, QKV, ODIFF_RAW, ODIL_RAW, LSE);
                const att::BlockRef nxt = attn_decode(s + 1 < total ? s + 1 : s, w, G, nd, QKV, ODIFF_RAW, ODIL_RAW, LSE);
                att::attn_block(cur, nxt, (char*)lds, S);
            }
        }
    }
    SEAM(5);
    if (IN(6)) {
        PHASE_TID();
        LAS float* scr = (LAS float*)(ldsl + wave * 16384);
        transpose_mat(args.in[21], DM, DFF, args.in[20], (bf16*)(ws + WS_W2GU), 1, scr, gw, NGW, lane);
        transpose_mat(args.in[22], DM, DFF, args.in[20], (bf16*)(ws + WS_W2GU), 2, scr, gw, NGW, lane);
        transpose_mat(args.in[23], DFF, DM, nullptr, (bf16*)(ws + WS_W2D), 0, scr, gw, NGW, lane);
        float lam;
        { const float a = args.in[12][lane] * args.in[13][lane] + args.in[12][lane + 64] * args.in[13][lane + 64];
          const float b = args.in[14][lane] * args.in[15][lane] + args.in[14][lane + 64] * args.in[15][lane + 64];
          lam = __expf(wave_sum(a)) - __expf(wave_sum(b)) + LAM_INIT; }
        const float* subln = args.in[16];
        for (int t = gw; t < M; t += NGW) {
            {
                const int h = lane >> 4;
                const float l0 = LSE[(size_t)t * 4 + h], l1 = LSE[(size_t)M * 4 + (size_t)t * 4 + h], l2 = LSE[(size_t)M * 8 + (size_t)t * 4 + h];
                const float mx = fmaxf(l0, fmaxf(l1, l2)); const float e0 = __expf(l0 - mx), e1 = __expf(l1 - mx), e2 = __expf(l2 - mx); const float inv = 1.0f / (e0 + e1 + e2);
                const float w0 = e0 * inv, w1 = e1 * inv, w2 = e2 * inv;
                const size_t off = (size_t)t * 512 + lane * 8;
                const v4u a = *(const v4u*)(ODIL_RAW + off), b = *(const v4u*)(ODIL_RAW + (size_t)M * 512 + off), c = *(const v4u*)(ODIL_RAW + (size_t)M * 1024 + off);
                v4u o;
                o.x = pk2(w0 * bflo(a.x) + w1 * bflo(b.x) + w2 * bflo(c.x), w0 * bfhi(a.x) + w1 * bfhi(b.x) + w2 * bfhi(c.x));
                o.y = pk2(w0 * bflo(a.y) + w1 * bflo(b.y) + w2 * bflo(c.y), w0 * bfhi(a.y) + w1 * bfhi(b.y) + w2 * bfhi(c.y));
                o.z = pk2(w0 * bflo(a.z) + w1 * bflo(b.z) + w2 * bflo(c.z), w0 * bfhi(a.z) + w1 * bfhi(b.z) + w2 * bfhi(c.z));
                o.w = pk2(w0 * bflo(a.w) + w1 * bflo(b.w) + w2 * bflo(c.w), w0 * bfhi(a.w) + w1 * bfhi(b.w) + w2 * bfhi(c.w));
                *(v4u*)(ODIL + off) = o;
            }
#pragma unroll
            for (int hh = 0; hh < 2; ++hh) {
                const int l32 = lane & 31;
                const size_t off = (size_t)t * 1024 + (size_t)(hh * 2 + (lane >> 5)) * 256 + l32 * 8;
                const v4u a = *(const v4u*)(ODIFF_RAW + off), b = *(const v4u*)(ODIFF_RAW + (size_t)M * 1024 + off);
                float d[8] = {bflo(a.x) - lam * bflo(b.x), bfhi(a.x) - lam * bfhi(b.x), bflo(a.y) - lam * bflo(b.y), bfhi(a.y) - lam * bfhi(b.y),
                              bflo(a.z) - lam * bflo(b.z), bfhi(a.z) - lam * bfhi(b.z), bflo(a.w) - lam * bflo(b.w), bfhi(a.w) - lam * bfhi(b.w)};
                float s = 0.f;
#pragma unroll
                for (int i = 0; i < 8; ++i) s += d[i] * d[i];
                s += __shfl_xor(s, 1); s += __shfl_xor(s, 2); s += __shfl_xor(s, 4); s += __shfl_xor(s, 8); s += __shfl_xor(s, 16);
                const float rs = rsqrtf(s * (1.0f / 256.0f) + RMS_EPS) * (1.0f - LAM_INIT);
                const f32x4 g0 = *(const f32x4*)(subln + l32 * 8), g1 = *(const f32x4*)(subln + l32 * 8 + 4);
                v4u o; o.x = pk2(d[0] * rs * g0[0], d[1] * rs * g0[1]); o.y = pk2(d[2] * rs * g0[2], d[3] * rs * g0[3]);
                o.z = pk2(d[4] * rs * g1[0], d[5] * rs * g1[1]); o.w = pk2(d[6] * rs * g1[2], d[7] * rs * g1[3]);
                *(v4u*)(ODIFF + off) = o;
            }
        }
    }
    SEAM(6);
    if (IN(7)) {
        { pg8::Gemm g{ODIL, (bf16*)(ws + WS_WDIL), M, DM, 512}; pg8::StaticOrder So; So.init(M, DM, G, bx);
          pg8::EpiGate<false> E{GATES, NGATE, 0, Y, DM};
          pg8::gemm_phase<pg8::EpiGate<false>, pg8::StaticOrder, true, true>(ldsl, g, So, E); }
        asm volatile("s_waitcnt vmcnt(0)" ::: "memory"); __syncthreads();
        { pg8::Gemm g{ODIFF, (bf16*)(ws + WS_WDIFF), M, DM, 1024}; pg8::StaticOrder So; So.init(M, DM, G, bx);
          pg8::EpiGate<true> E{GATES, NGATE, 2048, Y, DM};
          pg8::gemm_phase<pg8::EpiGate<true>, pg8::StaticOrder, true, true>(ldsl, g, So, E); }
    }
    SEAM(7);
    if (IN(8)) {
        pg8::Gemm g{Y, (bf16*)(ws + WS_WOUT), M, DM, DM}; pg8::StaticOrder So; So.init(M, DM, G, bx);
        pg8::EpiResid E{out, out, XB, SS3, 1.0f, DM};
        pg8::gemm_phase<pg8::EpiResid, pg8::StaticOrder, true, true>(ldsl, g, So, E);
    }
    SEAM(8);
    if (IN(9)) {
        pg8::Gemm g{XB, (bf16*)(ws + WS_W2GU), M, 2 * DFF, DM}; pg8::StaticOrder So; So.init(M, 2 * DFF, G, bx);
        pg8::EpiSwiglu E{(bf16*)(ws + WS_HID2), DFF, SS3};
        pg8::gemm_phase<pg8::EpiSwiglu, pg8::StaticOrder, true, true>(ldsl, g, So, E);
    }
    SEAM(9);
    if (IN(10)) {
        pg8::Gemm g{(bf16*)(ws + WS_HID2), (bf16*)(ws + WS_W2D), M, DM, DFF}; pg8::StaticOrder So; So.init(M, DM, G, bx);
        pg8::EpiResid E{out, out, nullptr, nullptr, 0.5f, DM};
        pg8::gemm_phase<pg8::EpiResid, pg8::StaticOrder, true, true>(ldsl, g, So, E);
    }
#undef IN
#undef SEAM
}

extern "C" void kernel_launch(void* const* d_in, const int* in_sizes, int n_in, void* d_out, int out_size, void* d_ws, size_t ws_size, hipStream_t stream) {
    static int grid = 0;
    if (grid == 0) {
        if (n_in != 24 || in_sizes[0] != M * DM || out_size != M * DM || ws_size < WS_END) {
            fprintf(stderr, "kernel_launch: unexpected shapes (n_in %d, in0 %d, out %d, ws %zu, need %zu)\n", n_in, n_in > 0 ? in_sizes[0] : -1, out_size, ws_size, (size_t)WS_END); grid = -1; return; }
        int dev = 0, cus = 0, per_cu = 0;
        if (hipGetDevice(&dev) != hipSuccess || hipDeviceGetAttribute(&cus, hipDeviceAttributeMultiprocessorCount, dev) != hipSuccess) { grid = -1; return; }
        if (hipFuncSetAttribute((const void*)layer_fwd, hipFuncAttributeMaxDynamicSharedMemorySize, LDS_BYTES) != hipSuccess) { fprintf(stderr, "kernel_launch: hipFuncSetAttribute failed\n"); grid = -1; return; }
        if (hipOccupancyMaxActiveBlocksPerMultiprocessor(&per_cu, (const void*)layer_fwd, NWAVES * 64, LDS_BYTES) != hipSuccess || per_cu < 1) { fprintf(stderr, "kernel_launch: occupancy query says %d\n", per_cu); per_cu = 1; }
        (void)hipGetLastError();
        grid = cus * per_cu;
    }
    if (grid < 0) return;
    Args a{};
    for (int i = 0; i < 24; ++i) a.in[i] = (const float*)d_in[i];
    a.out = (float*)d_out; a.ws = (unsigned char*)d_ws;
#if ONE_LAUNCH
    a.ph_lo = 0; a.ph_hi = NPHASE;
    void* kargs[] = {&a};
    hipError_t e = hipLaunchCooperativeKernel((const void*)layer_fwd, dim3(grid), dim3(NWAVES * 64), kargs, LDS_BYTES, stream);
    if (e != hipSuccess) fprintf(stderr, "kernel_launch: cooperative launch failed: %s (grid %d)\n", hipGetErrorString(e), grid);
#else
    for (int p = 0; p < NPHASE; ++p) { a.ph_lo = p; a.ph_hi = p + 1;
        hipLaunchKernelGGL(layer_fwd, dim3(grid), dim3(NWAVES * 64), LDS_BYTES, stream, a); }
#endif
}
```

```cpp
#include <hip/hip_runtime.h>
#include <hip/hip_cooperative_groups.h>
#include <cstdio>
#include <cstdint>
namespace cg = cooperative_groups;
#ifndef ONE_LAUNCH
#define ONE_LAUNCH 1
#endif
namespace pg8 {
#define PG8_LAS __attribute__((address_space(3)))
typedef unsigned short bf16_t;
typedef short bf16x8 __attribute__((ext_vector_type(8)));
typedef float f32x4 __attribute__((ext_vector_type(4)));
typedef unsigned u32x4 __attribute__((ext_vector_type(4)));
constexpr int BM = 256, BK = 64, HALF = 128, HTB = HALF * BK * 2  , STAGE_BYTES = 8 * HTB, NXCD = 8, WGM = 8;

__host__ __device__ __forceinline__ int lds_byte(int r, int c) { const int st = (r >> 4) * 2 + (c >> 5), rr = r & 15, cc = c & 31, ob = rr * 64 + cc * 2; return st * 1024 + (ob ^ (((ob >> 9) & 1) << 5)); }
__host__ __device__ __forceinline__ void stage_rc(int b, int& R, int& C) { const int st = b / 1024, sb = b % 1024, swz = sb ^ (((sb >> 9) & 1) << 5); R = (st >> 1) * 16 + swz / 64; C = (st & 1) * 32 + (swz % 64) / 2; }
__host__ __device__ __forceinline__ int perm32(int rho) { const int n = rho >> 4, i = rho & 15; return 8 * (i >> 2) + 4 * n + (i & 3); }

struct Unit { int pm, pn; };
struct Gemm { const bf16_t* A; const bf16_t* Bt; int M, N, K; };

struct StaticOrder {
    int nM, nN, nwg, G, c, wgm;
    __host__ __device__ void init(int M, int N, int G_, int c_, int wgm_ = WGM) { nM = M / BM; nN = N / BM; nwg = nM * nN; G = G_; c = c_; wgm = wgm_; }
    __host__ __device__ bool next(int i, Unit& u) const {
        const long L = (long)i * G + c; if (L >= nwg) return false;
        int wgid = (int)L; { const int q = nwg / NXCD, r = nwg % NXCD, xcd = wgid % NXCD, off = wgid / NXCD; wgid = (xcd < r ? xcd * (q + 1) : r * (q + 1) + (xcd - r) * q) + off; }
        const int nig = wgm * nN, gid = wgid / nig, fm = gid * wgm, gsz = (nM - fm) < wgm ? (nM - fm) : wgm;
        u.pm = fm + ((wgid % nig) % gsz); u.pn = (wgid % nig) / gsz; return true;
    }
    __device__ __forceinline__ void a_ready(const Unit&) const {}
    __device__ __forceinline__ void done(const Unit&) const {}
};
__device__ __forceinline__ unsigned cvt_pk_bf16(float lo, float hi) { unsigned r; asm volatile("v_cvt_pk_bf16_f32 %0, %1, %2" : "=v"(r) : "v"(lo), "v"(hi)); return r; }
constexpr float RMS_EPS = 1e-6f;
__device__ __forceinline__ float fast_sigmoid(float g) { return __builtin_amdgcn_rcpf(1.0f + __builtin_amdgcn_exp2f(-1.4426950408889634f * g)); }
__device__ __forceinline__ f32x4 bf2f_lo(unsigned a, unsigned b) { f32x4 r; r[0] = __uint_as_float(a << 16); r[1] = __uint_as_float(a & 0xffff0000u); r[2] = __uint_as_float(b << 16); r[3] = __uint_as_float(b & 0xffff0000u); return r; }

__device__ __forceinline__ float sum_xor32(float v) { auto r = __builtin_amdgcn_permlane32_swap(__float_as_uint(v), __float_as_uint(v), false, false); return __uint_as_float(r[0]) + __uint_as_float(r[1]); }
__device__ __forceinline__ float sum_xor16(float v) { auto r = __builtin_amdgcn_permlane16_swap(__float_as_uint(v), __float_as_uint(v), false, false); return __uint_as_float(r[0]) + __uint_as_float(r[1]); }
__device__ __forceinline__ float get_xor32(float v, bool upper) { auto r = __builtin_amdgcn_permlane32_swap(__float_as_uint(v), __float_as_uint(v), false, false); return __uint_as_float(upper ? r[0] : r[1]); }
template <bool KB64> struct EpiSwiglu {
    static constexpr bool PERM = true, AFTER_DRAIN = false, HAS_MID = false, KP = false;
    bf16_t* H; int ldh; const float* ss; int mrows;
    __device__ __forceinline__ void operator()(const f32x4 (&acc)[2][2][4][2], const Unit& u, int wr, int wc, int fr, int fq) const {
        const int row0 = u.pm * BM + wr * 64 + fr, col0 = u.pn * HALF + wc * 32 + 8 * fq;
#pragma unroll
        for (int ai = 0; ai < 2; ++ai)
#pragma unroll
            for (int m = 0; m < 4; ++m) { const int row = row0 + ai * HALF + m * 16; const float rs = rsqrtf(ss[row] * (1.0f / 2048.0f) + RMS_EPS);
                float h[8];
#pragma unroll
                for (int n = 0; n < 2; ++n)
#pragma unroll
                    for (int j = 0; j < 4; ++j) { const float g = acc[ai][0][m][n][j] * rs, up = acc[ai][1][m][n][j] * rs; h[n * 4 + j] = g * fast_sigmoid(g) * up; }
                u32x4 w; w.x = cvt_pk_bf16(h[0], h[1]); w.y = cvt_pk_bf16(h[2], h[3]); w.z = cvt_pk_bf16(h[4], h[5]); w.w = cvt_pk_bf16(h[6], h[7]);
                if (KB64) *(u32x4*)(H + (size_t)(col0 >> 6) * ((size_t)mrows * 64) + (size_t)row * 64 + (col0 & 63)) = w;
                else *(u32x4*)(H + (size_t)row * ldh + col0) = w; }
    }
};
template <bool BASE_F32, bool OUT_F32, bool NT_BASE = false> struct EpiResid {
    static constexpr bool PERM = true, AFTER_DRAIN = false, HAS_MID = false, KP = OUT_F32;
    const void* base; float* out; bf16_t* xb; float* ss; float alpha; int ld;
    __device__ __forceinline__ void operator()(const f32x4 (&acc)[2][2][4][2], const Unit& u, int wr, int wc, int fr, int fq) const {
        const int row0 = u.pm * BM + wr * 64 + fr, col0 = u.pn * BM + wc * 32 + 8 * fq;
#pragma unroll
        for (int ai = 0; ai < 2; ++ai) {
            f32x4 bf[4][2][2]; u32x4 bh[4][2];
#pragma unroll
            for (int m = 0; m < 4; ++m)
#pragma unroll
                for (int bj = 0; bj < 2; ++bj) { const size_t p = (size_t)(row0 + ai * HALF + m * 16) * ld + col0 + bj * HALF;
                    if (BASE_F32) { if (NT_BASE) { bf[m][bj][0] = __builtin_nontemporal_load((const f32x4*)((const float*)base + p)); bf[m][bj][1] = __builtin_nontemporal_load((const f32x4*)((const float*)base + p + 4)); }
                                    else { bf[m][bj][0] = *(const f32x4*)((const float*)base + p); bf[m][bj][1] = *(const f32x4*)((const float*)base + p + 4); } }
                    else { if (NT_BASE) bh[m][bj] = __builtin_nontemporal_load((const u32x4*)((const bf16_t*)base + p)); else bh[m][bj] = *(const u32x4*)((const bf16_t*)base + p); } }
            asm volatile("" ::: "memory");
#pragma unroll
            for (int m = 0; m < 4; ++m) { const int row = row0 + ai * HALF + m * 16; float s = 0.f;
#pragma unroll
                for (int bj = 0; bj < 2; ++bj) { const size_t p = (size_t)row * ld + col0 + bj * HALF;
                    f32x4 b0, b1;
                    if (BASE_F32) { b0 = bf[m][bj][0]; b1 = bf[m][bj][1]; }
                    else { b0 = bf2f_lo(bh[m][bj].x, bh[m][bj].y); b1 = bf2f_lo(bh[m][bj].z, bh[m][bj].w); }
                    const f32x4 v0 = b0 + acc[ai][bj][m][0] * alpha, v1 = b1 + acc[ai][bj][m][1] * alpha;
                    if (OUT_F32) { __builtin_nontemporal_store(v0, (f32x4*)(out + p)); __builtin_nontemporal_store(v1, (f32x4*)(out + p + 4)); }
                    if (xb) { u32x4 w; w.x = cvt_pk_bf16(v0[0], v0[1]); w.y = cvt_pk_bf16(v0[2], v0[3]); w.z = cvt_pk_bf16(v1[0], v1[1]); w.w = cvt_pk_bf16(v1[2], v1[3]); *(u32x4*)(xb + p) = w; }
                    s += (v0[0] * v0[0] + v0[1] * v0[1]) + (v0[2] * v0[2] + v0[3] * v0[3]) + (v1[0] * v1[0] + v1[1] * v1[1]) + (v1[2] * v1[2] + v1[3] * v1[3]); }
                if (ss) { s = sum_xor16(s); s = sum_xor32(s); if (fq == 0) atomicAdd(ss + row, s); } }
            asm volatile("" ::: "memory");
        }
    }
};
struct EpiProj {
    static constexpr bool PERM = true, AFTER_DRAIN = false, HAS_MID = false, KP = false;
    bf16_t* O0; int ld0; bf16_t* O1; int ld1; int split_pn; const float* ss;
    const float* gdq; const float* gdk; const float* gfq; const float* gfk; const float* cosT; const float* sinT; PG8_LAS float* P;
    __device__ __forceinline__ void operator()(const f32x4 (&acc_)[2][2][4][2], const Unit& u, int wr, int wc, int fr, int fq) const {
        f32x4 (&acc)[2][2][4][2] = const_cast<f32x4 (&)[2][2][4][2]>(acc_);
        const int pn = u.pn;
        const int kind = pn < 6 ? 0 : (pn < 12 ? 1 : ((pn >= 18 && pn < 22) ? 2 : ((pn >= 22 && pn < 26) ? 3 : -1)));
        const int rl0 = wr * 64 + fr, row0 = pn * 0 + u.pm * BM + rl0; const bool first = pn < split_pn;
        bf16_t* O = first ? O0 : O1; const int ld = first ? ld0 : ld1; const int col0 = (first ? pn : pn - split_pn) * BM + wc * 32 + 8 * fq;
#pragma unroll
        for (int ai = 0; ai < 2; ++ai)
#pragma unroll
            for (int m = 0; m < 4; ++m) { const int rl = rl0 + ai * HALF + m * 16; const float rs = rsqrtf(ss[u.pm * BM + rl] * (1.0f / 2048.0f) + RMS_EPS);
#pragma unroll
                for (int bj = 0; bj < 2; ++bj) { acc[ai][bj][m][0] = acc[ai][bj][m][0] * rs; acc[ai][bj][m][1] = acc[ai][bj][m][1] * rs;
                    if (kind >= 0) { const f32x4 a = acc[ai][bj][m][0], b = acc[ai][bj][m][1];
                        float s = (a[0] * a[0] + a[1] * a[1]) + (a[2] * a[2] + a[3] * a[3]) + (b[0] * b[0] + b[1] * b[1]) + (b[2] * b[2] + b[3] * b[3]);
                        s = sum_xor16(s); s = sum_xor32(s);
                        if (fq == 0) P[(rl * 2 + bj) * 4 + wc] = s; } } }
        f32x4 g0 = {1.f, 1.f, 1.f, 1.f}, g1 = g0;
        if (kind >= 0) {
            asm volatile("s_waitcnt lgkmcnt(0)" ::: "memory"); __builtin_amdgcn_s_barrier(); asm volatile("" ::: "memory");
            const float* gp = (kind == 0 ? gdq : (kind == 1 ? gdk : (kind == 2 ? gfq : gfk))) + wc * 32 + 8 * fq;
            g0 = *(const f32x4*)gp; g1 = *(const f32x4*)(gp + 4);
        }
        const bool rope = kind >= 0 && wc == 0; const float sgn = fq < 2 ? -1.0f : 1.0f;
#pragma unroll
        for (int ai = 0; ai < 2; ++ai)
#pragma unroll
            for (int m = 0; m < 4; ++m) { const int rl = rl0 + ai * HALF + m * 16, row = u.pm * BM + rl;
                f32x4 c0, c1, s0, s1;
                if (rope) { const float* cp = cosT + (size_t)row * 16 + 8 * (fq & 1); const float* sp = sinT + (size_t)row * 16 + 8 * (fq & 1);
                    c0 = *(const f32x4*)cp; c1 = *(const f32x4*)(cp + 4); s0 = *(const f32x4*)sp; s1 = *(const f32x4*)(sp + 4); }
#pragma unroll
                for (int bj = 0; bj < 2; ++bj) { f32x4 v0 = acc[ai][bj][m][0], v1 = acc[ai][bj][m][1];
                    if (kind >= 0) { const f32x4 p4 = *(const PG8_LAS f32x4*)(P + (rl * 2 + bj) * 4);
                        const float rh = rsqrtf(((p4[0] + p4[1]) + (p4[2] + p4[3])) * (1.0f / 128.0f) + RMS_EPS);
                        v0 = v0 * rh * g0; v1 = v1 * rh * g1;
                        if (rope) {
#pragma unroll
                            for (int j = 0; j < 4; ++j) { const float p0 = get_xor32(v0[j], fq >= 2), p1 = get_xor32(v1[j], fq >= 2);
                                v0[j] = v0[j] * c0[j] + sgn * p0 * s0[j]; v1[j] = v1[j] * c1[j] + sgn * p1 * s1[j]; } } }
                    u32x4 w; w.x = cvt_pk_bf16(v0[0], v0[1]); w.y = cvt_pk_bf16(v0[2], v0[3]); w.z = cvt_pk_bf16(v1[0], v1[1]); w.w = cvt_pk_bf16(v1[2], v1[3]);
                    *(u32x4*)(O + (size_t)row * ld + col0 + bj * HALF) = w; } }
    }
};
struct EpiGateMerge {
    static constexpr bool PERM = true, AFTER_DRAIN = false, HAS_MID = true, KP = false;
    const bf16_t* gate; int ldg; bf16_t* Y; int ldy; int mid_t;
    __device__ __forceinline__ void mid(f32x4 (&acc)[2][2][4][2], const Unit& u, int wr, int wc, int fr, int fq) const {
        int row0 = u.pm * BM + wr * 64 + fr, col0 = u.pn * BM + wc * 32 + 8 * fq;
        asm volatile("" : "+v"(row0), "+v"(col0));
#pragma unroll
        for (int ai = 0; ai < 2; ++ai)
#pragma unroll
            for (int m = 0; m < 4; ++m)
#pragma unroll
                for (int bj = 0; bj < 2; ++bj) { const bf16_t* gp = gate + (size_t)(row0 + ai * HALF + m * 16) * ldg + col0 + bj * HALF;
                    const u32x4 ga = *(const u32x4*)gp, gb = *(const u32x4*)(gp + 2048);
                    const f32x4 a0 = bf2f_lo(ga.x, ga.y), a1 = bf2f_lo(ga.z, ga.w), b0 = bf2f_lo(gb.x, gb.y), b1 = bf2f_lo(gb.z, gb.w);
#pragma unroll
                    for (int j = 0; j < 4; ++j) {
                        acc[ai][bj][m][0][j] *= (1.0f + __builtin_amdgcn_exp2f(-1.4426950408889634f * b0[j])) * __builtin_amdgcn_rcpf(1.0f + __builtin_amdgcn_exp2f(-1.4426950408889634f * a0[j]));
                        acc[ai][bj][m][1][j] *= (1.0f + __builtin_amdgcn_exp2f(-1.4426950408889634f * b1[j])) * __builtin_amdgcn_rcpf(1.0f + __builtin_amdgcn_exp2f(-1.4426950408889634f * a1[j])); }
                    asm volatile("" ::: "memory"); }
    }
    __device__ __forceinline__ void operator()(const f32x4 (&acc)[2][2][4][2], const Unit& u, int wr, int wc, int fr, int fq) const {
        const int row0 = u.pm * BM + wr * 64 + fr, col0 = u.pn * BM + wc * 32 + 8 * fq;
#pragma unroll
        for (int ai = 0; ai < 2; ++ai)
#pragma unroll
            for (int m = 0; m < 4; ++m) { const int row = row0 + ai * HALF + m * 16;
#pragma unroll
                for (int bj = 0; bj < 2; ++bj) { const int col = col0 + bj * HALF;
                    const u32x4 gw = *(const u32x4*)(gate + (size_t)row * ldg + 2048 + col);
                    const f32x4 g0 = bf2f_lo(gw.x, gw.y), g1 = bf2f_lo(gw.z, gw.w);
                    f32x4 v0, v1;
#pragma unroll
                    for (int j = 0; j < 4; ++j) { v0[j] = fast_sigmoid(g0[j]) * acc[ai][bj][m][0][j]; v1[j] = fast_sigmoid(g1[j]) * acc[ai][bj][m][1][j]; }
                    u32x4 w; w.x = cvt_pk_bf16(v0[0], v0[1]); w.y = cvt_pk_bf16(v0[2], v0[3]); w.z = cvt_pk_bf16(v1[0], v1[1]); w.w = cvt_pk_bf16(v1[2], v1[3]);
                    *(u32x4*)(Y + (size_t)row * ldy + col) = w; } }
    }
};

template <class Epi, class Sched, bool ALIGN_EPI = false, bool SP2 = false, bool KB64 = false>
__device__ __forceinline__ void gemm_phase(PG8_LAS unsigned char* lds, const Gemm g, const Sched& S, const Epi& E) {
    int tid_ = threadIdx.x; asm volatile("" : "+v"(tid_));
    const int tid = tid_, wid = __builtin_amdgcn_readfirstlane(tid >> 6), lane = tid & 63, wr = wid >> 2, wc = wid & 3, fr = lane & 15, fq = lane >> 4;
    const int K = g.K, nt = K / BK;
    unsigned voffA[2], voffB[2];
#pragma unroll
    for (int i = 0; i < 2; ++i) { int R, C; stage_rc(tid * 16 + i * 8192, R, C); const int Rb = Epi::PERM ? ((R & ~31) + perm32(R & 31)) : R;
        voffA[i] = (unsigned)(R * (KB64 ? 64 : K) + C) * 2u; voffB[i] = (unsigned)(Rb * (KB64 ? 64 : K) + C) * 2u; }
    const size_t kstepA = KB64 ? (size_t)g.M * (BK * 2) : (size_t)(BK * 2), kstepB = KB64 ? (size_t)g.N * (BK * 2) : (size_t)(BK * 2);
    const size_t hstep = KB64 ? (size_t)HALF * BK * 2 : (size_t)HALF * K * 2;
    const size_t tstep = 2 * hstep;
    const unsigned ldsw = (unsigned)wid * 1024u;
    const int aoff = lds_byte(wr * 64 + fr, fq * 8), boff = lds_byte(wc * 32 + fr, fq * 8);
#define PG8_SA(b, h) (((b) * 2 + (h)) * HTB)
#define PG8_SB(b, h) ((4 + (b) * 2 + (h)) * HTB)
#define PG8_STAGE(bufoff, gbase, voff) do { _Pragma("unroll") for (int _i = 0; _i < 2; ++_i) \
        __builtin_amdgcn_global_load_lds((const unsigned*)((const char*)(gbase) + (voff)[_i]), (PG8_LAS unsigned*)(lds + (bufoff) + ldsw + _i * 8192), 16, 0, 0); } while (0)
#define PG8_LDA(dst, b, h) do { _Pragma("unroll") for (int m = 0; m < 4; ++m) _Pragma("unroll") for (int k = 0; k < 2; ++k) dst[m][k] = *(const PG8_LAS bf16x8*)(lds + PG8_SA(b, h) + aoff + m * 2048 + k * 1024); } while (0)
#define PG8_LDB(dst, b, h) do { _Pragma("unroll") for (int n = 0; n < 2; ++n) _Pragma("unroll") for (int k = 0; k < 2; ++k) dst[n][k] = *(const PG8_LAS bf16x8*)(lds + PG8_SB(b, h) + boff + n * 2048 + k * 1024); } while (0)
#define PG8_MMA(ai, bj, At, Bt) do { __builtin_amdgcn_s_setprio(1); _Pragma("unroll") for (int m = 0; m < 4; ++m) _Pragma("unroll") for (int n = 0; n < 2; ++n) _Pragma("unroll") for (int k = 0; k < 2; ++k) \
        acc[ai][bj][m][n] = __builtin_amdgcn_mfma_f32_16x16x32_bf16(Bt[n][k], At[m][k], acc[ai][bj][m][n], 0, 0, 0); __builtin_amdgcn_s_setprio(0); } while (0)
#define PG8_WAIT_V(n) asm volatile("s_waitcnt vmcnt(" #n ")" ::: "memory")
#define PG8_WAIT_L(n) asm volatile("s_waitcnt lgkmcnt(" #n ")" ::: "memory")
#define PG8_BAR __builtin_amdgcn_s_barrier()
#define PG8_SCHED __builtin_amdgcn_sched_barrier(0)
    Unit cur, nxt; int ui = 0;
    if (!S.next(0, cur)) return;
    f32x4 acc[2][2][4][2];
#pragma unroll
    for (int a = 0; a < 2; ++a)
#pragma unroll
        for (int b = 0; b < 2; ++b)
#pragma unroll
            for (int m = 0; m < 4; ++m)
#pragma unroll
                for (int n = 0; n < 2; ++n) acc[a][b][m][n] = (f32x4){0.f, 0.f, 0.f, 0.f};
    bf16x8 At[4][2], B0[2][2], B1[2][2];
    const char* cA = (const char*)g.A + (size_t)cur.pm * tstep; const char* cB = (const char*)g.Bt + (size_t)cur.pn * tstep;
    S.a_ready(cur);
    if constexpr (SP2) {
        PG8_STAGE(PG8_SB(0, 0), cB, voffB); PG8_STAGE(PG8_SB(0, 1), cB + hstep, voffB); PG8_STAGE(PG8_SA(0, 0), cA, voffA); PG8_STAGE(PG8_SA(0, 1), cA + hstep, voffA);
        if (wr == 1) PG8_BAR;
        PG8_WAIT_V(2); PG8_BAR;
        PG8_STAGE(PG8_SB(1, 0), cB + kstepB, voffB); PG8_STAGE(PG8_SA(1, 0), cA + kstepA, voffA); PG8_STAGE(PG8_SB(1, 1), cB + hstep + kstepB, voffB);
        PG8_WAIT_V(6); PG8_BAR;
    } else {
        PG8_STAGE(PG8_SB(0, 0), cB, voffB); PG8_STAGE(PG8_SA(0, 0), cA, voffA); PG8_STAGE(PG8_SB(0, 1), cB + hstep, voffB); PG8_STAGE(PG8_SA(0, 1), cA + hstep, voffA);
        if (wr == 1) PG8_BAR;
        PG8_WAIT_V(4); PG8_BAR;
        PG8_STAGE(PG8_SB(1, 0), cB + kstepB, voffB); PG8_STAGE(PG8_SA(1, 0), cA + kstepA, voffA); PG8_STAGE(PG8_SB(1, 1), cB + hstep + kstepB, voffB);
        PG8_WAIT_V(6); PG8_BAR;
    }
    for (;;) {
        const bool has_next = S.next(ui + 1, nxt);
        const char* nA = has_next ? (const char*)g.A + (size_t)nxt.pm * tstep : cA; const char* nB = has_next ? (const char*)g.Bt + (size_t)nxt.pn * tstep : cB;
#ifdef PROBE_KLOOP
#ifdef PROBE_KCYC
        const unsigned long long pk_t0 = __builtin_amdgcn_s_memtime();
#else
        const unsigned long long pk_t0 = __builtin_amdgcn_s_memrealtime();
#endif
#endif
        for (int t = 0; t < nt; t += 2) {
            const bool last = (t == nt - 2);
            const char* a1 = cA + (size_t)(t + 1) * kstepA;
            const char* a2 = last ? nA : cA + (size_t)(t + 2) * kstepA; const char* b2 = last ? nB : cB + (size_t)(t + 2) * kstepB;
            const char* a3 = a2 + kstepA; const char* b3 = b2 + kstepB;
#ifdef KPAUSE
            if constexpr (Epi::KP) { if (t == 32 || t == 64) { __builtin_amdgcn_s_sleep(KPAUSE); } }
#endif
            if constexpr (Epi::HAS_MID) { if (t == E.mid_t) E.mid(acc, cur, wr, wc, fr, fq); }
            if (last && has_next) S.a_ready(nxt);
            if constexpr (SP2) {
            PG8_LDB(B0, 0, 0); PG8_LDB(B1, 0, 1); PG8_SCHED; PG8_LDA(At, 0, 0); PG8_STAGE(PG8_SA(1, 1), a1 + hstep, voffA);
            PG8_WAIT_V(8); PG8_WAIT_L(0); PG8_BAR; PG8_MMA(0, 0, At, B0); PG8_MMA(0, 1, At, B1); PG8_BAR; PG8_SCHED;
            PG8_LDA(At, 0, 1); PG8_STAGE(PG8_SB(0, 0), b2, voffB); PG8_STAGE(PG8_SB(0, 1), b2 + hstep, voffB); PG8_STAGE(PG8_SA(0, 0), a2, voffA);
            PG8_WAIT_V(8); PG8_WAIT_L(0); PG8_BAR; PG8_MMA(1, 0, At, B0); PG8_MMA(1, 1, At, B1); PG8_BAR; PG8_SCHED;
            PG8_LDB(B0, 1, 0); PG8_LDB(B1, 1, 1); PG8_SCHED; PG8_LDA(At, 1, 0); PG8_STAGE(PG8_SA(0, 1), a2 + hstep, voffA);
            PG8_WAIT_V(8); PG8_WAIT_L(0); PG8_BAR; PG8_MMA(0, 0, At, B0); PG8_MMA(0, 1, At, B1); PG8_BAR; PG8_SCHED;
            PG8_LDA(At, 1, 1); PG8_STAGE(PG8_SB(1, 0), b3, voffB); PG8_STAGE(PG8_SB(1, 1), b3 + hstep, voffB); PG8_STAGE(PG8_SA(1, 0), a3, voffA);
            PG8_WAIT_V(8); PG8_WAIT_L(0); PG8_BAR; PG8_MMA(1, 0, At, B0); PG8_MMA(1, 1, At, B1); PG8_BAR; PG8_SCHED;
            } else {
            PG8_LDB(B0, 0, 0); PG8_SCHED; PG8_LDA(At, 0, 0); PG8_STAGE(PG8_SA(1, 1), a1 + hstep, voffA);
            PG8_WAIT_L(8); PG8_BAR; PG8_WAIT_L(0); PG8_MMA(0, 0, At, B0); PG8_BAR; PG8_SCHED;
            PG8_LDB(B1, 0, 1); PG8_STAGE(PG8_SB(0, 0), b2, voffB);
            PG8_BAR; PG8_WAIT_L(0); PG8_MMA(0, 1, At, B1); PG8_BAR;
            PG8_LDA(At, 0, 1); PG8_STAGE(PG8_SA(0, 0), a2, voffA);
            PG8_BAR; PG8_WAIT_L(0); PG8_MMA(1, 0, At, B0); PG8_BAR; PG8_SCHED;
            PG8_STAGE(PG8_SB(0, 1), b2 + hstep, voffB);
            PG8_WAIT_V(6); PG8_BAR; PG8_MMA(1, 1, At, B1); PG8_BAR;
            PG8_LDB(B0, 1, 0); PG8_SCHED; PG8_LDA(At, 1, 0); PG8_STAGE(PG8_SA(0, 1), a2 + hstep, voffA);
            PG8_WAIT_L(8); PG8_BAR; PG8_WAIT_L(0); PG8_MMA(0, 0, At, B0); PG8_BAR; PG8_SCHED;
            PG8_LDB(B1, 1, 1); PG8_STAGE(PG8_SB(1, 0), b3, voffB);
            PG8_BAR; PG8_WAIT_L(0); PG8_MMA(0, 1, At, B1); PG8_BAR;
            PG8_LDA(At, 1, 1); PG8_STAGE(PG8_SA(1, 0), a3, voffA);
            PG8_BAR; PG8_WAIT_L(0); PG8_MMA(1, 0, At, B0); PG8_BAR; PG8_SCHED;
            PG8_STAGE(PG8_SB(1, 1), b3 + hstep, voffB);
            PG8_WAIT_V(6); PG8_BAR; PG8_MMA(1, 1, At, B1); PG8_BAR;
            }
        }
#ifdef PROBE_KLOOP
#ifdef PROBE_KCYC
        if (tid == 0) *(PG8_LAS unsigned*)(lds + 139264 + 64) += (unsigned)((__builtin_amdgcn_s_memtime() - pk_t0) / 20);
#else
        if (tid == 0) *(PG8_LAS unsigned*)(lds + 139264 + 64) += (unsigned)(__builtin_amdgcn_s_memrealtime() - pk_t0);
#endif
#endif
        if constexpr (ALIGN_EPI) { if (wr == 0) PG8_BAR; }
        if constexpr (!Epi::AFTER_DRAIN) { E(acc, cur, wr, wc, fr, fq); S.done(cur); }
        if (!has_next) break;
#pragma unroll
        for (int a = 0; a < 2; ++a)
#pragma unroll
            for (int b = 0; b < 2; ++b)
#pragma unroll
                for (int m = 0; m < 4; ++m)
#pragma unroll
                    for (int n = 0; n < 2; ++n) acc[a][b][m][n] = (f32x4){0.f, 0.f, 0.f, 0.f};
        cur = nxt; cA = nA; cB = nB; ++ui;
        if constexpr (ALIGN_EPI) { if (wr == 1) PG8_BAR; }
    }
    PG8_WAIT_V(0);
    if constexpr (!ALIGN_EPI) { if (wr == 0) PG8_BAR; }
    PG8_BAR;
    if constexpr (Epi::AFTER_DRAIN) { E.fused(acc, cur, wr, wc, fr, fq, lds, wid, lane); S.done(cur); }
#undef PG8_SA
#undef PG8_SB
#undef PG8_STAGE
#undef PG8_LDA
#undef PG8_LDB
#undef PG8_MMA
#undef PG8_WAIT_V
#undef PG8_WAIT_L
#undef PG8_BAR
#undef PG8_SCHED
}
}
namespace att {
typedef unsigned short bf16_t;
typedef short bf16x8 __attribute__((ext_vector_type(8)));
typedef short s16x4 __attribute__((ext_vector_type(4)));
typedef float f32x16 __attribute__((ext_vector_type(16)));
typedef float f32x4 __attribute__((ext_vector_type(4)));
typedef unsigned u32x4 __attribute__((ext_vector_type(4)));
constexpr int D = 128;
constexpr float SCALE = 0.08838834764831845f;
constexpr float THR = 8.f;
constexpr int NW = 8, QBLK = 32, KVBLK = 64, QB = NW * QBLK;
constexpr int SHM_V = KVBLK * D * 2, SHM_K = KVBLK * D * 2;
constexpr int LDS_BYTES = 2 * SHM_V + 2 * SHM_K + NW * 64 * 4;

#define KSWZ(row, colB) ((row) * 256 + ((colB) ^ (((row) & 7) << 4)))
#define SBAR() __builtin_amdgcn_sched_barrier(0)
__device__ __forceinline__ int v_st(int k, int c) { const int kk = (k & ~0xC) | ((k & 4) << 1) | ((k & 8) >> 1); return ((kk >> 3) * 4 + (c >> 5)) * 512 + ((kk & 7) * 32 + (c & 31)) * 2; }
__device__ __forceinline__ int v_rd_base(int lane) { return ((lane & 3) << 3) | (((lane >> 2) & 3) << 6) | (((lane >> 4) & 1) << 5) | (((lane >> 5) & 1) << 8); }
constexpr int v_rd_off(int d0, int ks, int half) { return d0 * 512 + ks * 4096 + half * 2048; }
__device__ __forceinline__ int crow(int r, int hi) { return (r & 3) + 8 * (r >> 2) + 4 * hi; }
__device__ __forceinline__ unsigned cvtpk(float lo, float hi) { unsigned r; asm volatile("v_cvt_pk_bf16_f32 %0, %1, %2" : "=v"(r) : "v"(lo), "v"(hi)); return r; }
__device__ __forceinline__ bf16x8 ld8(const bf16_t* p) { return *reinterpret_cast<const bf16x8*>(p); }
__device__ __forceinline__ void mask_tile(f32x16& p0, f32x16& p1, int dq, unsigned W) {
    const float NEG = -__builtin_inff();
#pragma unroll
    for (int r = 0; r < 16; ++r) {
        const int c = (r & 3) + 8 * (r >> 2);
        if ((unsigned)(dq - c) >= W) p0[r] = NEG;
        if ((unsigned)(dq - c - 32) >= W) p1[r] = NEG;
    }
}
__device__ __forceinline__ void partialSM(f32x16& p0, f32x16& p1, float& m_reg, float& mn, float& alpha) {
    float pmax = p0[0]; for (int r = 1; r < 16; ++r) pmax = fmaxf(pmax, p0[r]); for (int r = 0; r < 16; ++r) pmax = fmaxf(pmax, p1[r]);
    { auto rr = __builtin_amdgcn_permlane32_swap(__float_as_uint(pmax), __float_as_uint(pmax), false, false);
      pmax = fmaxf(__uint_as_float(rr[0]), __uint_as_float(rr[1])); }
    constexpr float C2 = 1.4426950408889634f * SCALE;
    if (__builtin_expect(__all((pmax - m_reg) * SCALE <= THR), 1)) { mn = m_reg; alpha = 1.f; }
    else { mn = fmaxf(m_reg, pmax); alpha = __builtin_amdgcn_exp2f((m_reg - mn) * C2); m_reg = mn; }
    const float mnL = -mn * C2;
    for (int r = 0; r < 16; ++r) p0[r] = fmaf(p0[r], C2, mnL); for (int r = 0; r < 16; ++r) p1[r] = fmaf(p1[r], C2, mnL);
    for (int r = 0; r < 16; ++r) p0[r] = __builtin_amdgcn_exp2f(p0[r]);
}
__device__ __forceinline__ void finishSM(f32x16& p0, f32x16& p1, float alpha, float& l_reg, bf16x8& pa0, bf16x8& pa1, bf16x8& pa2, bf16x8& pa3) {
    for (int r = 0; r < 16; ++r) p1[r] = __builtin_amdgcn_exp2f(p1[r]);
    float ps = 0; for (int r = 0; r < 16; ++r) ps += p0[r]; for (int r = 0; r < 16; ++r) ps += p1[r];
    { auto rr = __builtin_amdgcn_permlane32_swap(__float_as_uint(ps), __float_as_uint(ps), false, false);
      ps = __uint_as_float(rr[0]) + __uint_as_float(rr[1]); }
    l_reg = l_reg * alpha + ps;
#define PK4(P, B_, OUT) do { unsigned a0 = cvtpk(P[B_+0], P[B_+1]), a1 = cvtpk(P[B_+2], P[B_+3]);                          \
        unsigned b0 = cvtpk(P[B_+4], P[B_+5]), b1 = cvtpk(P[B_+6], P[B_+7]);                                             \
        auto r0 = __builtin_amdgcn_permlane32_swap(a0, b0, false, false); auto r1 = __builtin_amdgcn_permlane32_swap(a1, b1, false, false); \
        u32x4 w = {r0[0], r1[0], r0[1], r1[1]}; OUT = *reinterpret_cast<bf16x8*>(&w); } while (0)
    PK4(p0, 0, pa0); PK4(p0, 8, pa1); PK4(p1, 0, pa2); PK4(p1, 8, pa3);
#undef PK4
}
template <int KB>
__device__ __forceinline__ void qkt(f32x16& p0, f32x16& p1, const char* K_lds, int r32, int hi, const bf16x8* qr) {
    p0 = f32x16{}; p1 = f32x16{};
    const char* kb[4];
#pragma unroll
    for (int dd = 0; dd < 4; ++dd) kb[dd] = K_lds + KB * SHM_K + KSWZ(r32, (dd * 16 + hi * 8) * 2);
#pragma unroll
    for (int d0 = 0; d0 < 8; ++d0) { const char* a = kb[d0 & 3] + (d0 >> 2) * 128;
        bf16x8 b0 = *reinterpret_cast<const bf16x8*>(a);
        bf16x8 b1 = *reinterpret_cast<const bf16x8*>(a + 32 * 256);
        p0 = __builtin_amdgcn_mfma_f32_32x32x16_bf16(b0, qr[d0], p0, 0, 0, 0);
        p1 = __builtin_amdgcn_mfma_f32_32x32x16_bf16(b1, qr[d0], p1, 0, 0, 0); }
}
template <int VB, int VSTRIDE = SHM_V>
__device__ __forceinline__ void pv_tile(f32x16* o, int vb0, bf16x8 pa0, bf16x8 pa1, bf16x8 pa2, bf16x8 pa3) {
#define TRRD(dst, off) asm volatile("ds_read_b64_tr_b16 %0, %1 offset:%2" : "=&v"(dst) : "v"(vb0), "i"(off) : "memory")
#define PV_D0(d0) do { s16x4 l0, l1, l2, l3, h0, h1, h2, h3; constexpr int b_ = VB * VSTRIDE + v_rd_off(d0, 0, 0);   \
        TRRD(l0, b_); TRRD(h0, b_ + 2048); TRRD(l1, b_ + 4096); TRRD(h1, b_ + 6144); TRRD(l2, b_ + 8192); TRRD(h2, b_ + 10240); TRRD(l3, b_ + 12288); TRRD(h3, b_ + 14336); \
        asm volatile("s_waitcnt lgkmcnt(0)" ::: "memory"); SBAR();   \
        o[d0] = __builtin_amdgcn_mfma_f32_32x32x16_bf16(pa0, (bf16x8){l0[0], l0[1], l0[2], l0[3], h0[0], h0[1], h0[2], h0[3]}, o[d0], 0, 0, 0);   \
        o[d0] = __builtin_amdgcn_mfma_f32_32x32x16_bf16(pa1, (bf16x8){l1[0], l1[1], l1[2], l1[3], h1[0], h1[1], h1[2], h1[3]}, o[d0], 0, 0, 0);   \
        o[d0] = __builtin_amdgcn_mfma_f32_32x32x16_bf16(pa2, (bf16x8){l2[0], l2[1], l2[2], l2[3], h2[0], h2[1], h2[2], h2[3]}, o[d0], 0, 0, 0);   \
        o[d0] = __builtin_amdgcn_mfma_f32_32x32x16_bf16(pa3, (bf16x8){l3[0], l3[1], l3[2], l3[3], h3[0], h3[1], h3[2], h3[3]}, o[d0], 0, 0, 0); } while (0)
    PV_D0(0); PV_D0(1); PV_D0(2); PV_D0(3);
#undef PV_D0
#undef TRRD
}


template <int B>
__device__ __forceinline__ void pv_wide(f32x16* o, int vb0, bf16x8 pa0, bf16x8 pa1, bf16x8 pa2, bf16x8 pa3) {
#define TRRD(dst, off) asm volatile("ds_read_b64_tr_b16 %0, %1 offset:%2" : "=&v"(dst) : "v"(vb0), "i"(off) : "memory")
#define RD8(S, g) do { constexpr int b_ = B * 32768 + ((g) >> 2) * 16384 + v_rd_off((g) & 3, 0, 0); \
        TRRD(S##l0, b_); TRRD(S##h0, b_ + 2048); TRRD(S##l1, b_ + 4096); TRRD(S##h1, b_ + 6144); TRRD(S##l2, b_ + 8192); TRRD(S##h2, b_ + 10240); TRRD(S##l3, b_ + 12288); TRRD(S##h3, b_ + 14336); } while (0)
#define MM4(S, g) do { \
        o[g] = __builtin_amdgcn_mfma_f32_32x32x16_bf16(pa0, (bf16x8){S##l0[0], S##l0[1], S##l0[2], S##l0[3], S##h0[0], S##h0[1], S##h0[2], S##h0[3]}, o[g], 0, 0, 0); \
        o[g] = __builtin_amdgcn_mfma_f32_32x32x16_bf16(pa1, (bf16x8){S##l1[0], S##l1[1], S##l1[2], S##l1[3], S##h1[0], S##h1[1], S##h1[2], S##h1[3]}, o[g], 0, 0, 0); \
        o[g] = __builtin_amdgcn_mfma_f32_32x32x16_bf16(pa2, (bf16x8){S##l2[0], S##l2[1], S##l2[2], S##l2[3], S##h2[0], S##h2[1], S##h2[2], S##h2[3]}, o[g], 0, 0, 0); \
        o[g] = __builtin_amdgcn_mfma_f32_32x32x16_bf16(pa3, (bf16x8){S##l3[0], S##l3[1], S##l3[2], S##l3[3], S##h3[0], S##h3[1], S##h3[2], S##h3[3]}, o[g], 0, 0, 0); } while (0)
#define LW8() do { asm volatile("s_waitcnt lgkmcnt(8)" ::: "memory"); SBAR(); } while (0)
    s16x4 Al0, Al1, Al2, Al3, Ah0, Ah1, Ah2, Ah3, Bl0, Bl1, Bl2, Bl3, Bh0, Bh1, Bh2, Bh3;
    RD8(A, 0);
    RD8(B, 1); LW8(); MM4(A, 0); SBAR();
    RD8(A, 2); LW8(); MM4(B, 1); SBAR();
    RD8(B, 3); LW8(); MM4(A, 2); SBAR();
    RD8(A, 4); LW8(); MM4(B, 3); SBAR();
    RD8(B, 5); LW8(); MM4(A, 4); SBAR();
    RD8(A, 6); LW8(); MM4(B, 5); SBAR();
    RD8(B, 7); LW8(); MM4(A, 6); SBAR();
    asm volatile("s_waitcnt lgkmcnt(0)" ::: "memory"); SBAR(); MM4(B, 7);
#undef LW8
#undef MM4
#undef RD8
#undef TRRD
}

struct BlockRef { const bf16_t* Q; const bf16_t* K; const bf16_t* V; bf16_t* O; float* LSE; int rs, os, ls, P0, W, skv; };
struct Seam { bf16x8 qr[8]; bf16x8 st_v0, st_v1, st_k0, st_k1; };
__device__ __forceinline__ int swa_jlo(int P0, int W) { const int lowk = P0 - W + 1; return lowk > 0 ? lowk / KVBLK : 0; }
#define VMW() asm volatile("s_waitcnt vmcnt(0)" ::: "memory")
#define VMWN(n) asm volatile("s_waitcnt vmcnt(%0)" :: "i"(n) : "memory")
#define SLOAD_H(Kp, Vp, RS, k0) do { const bf16_t* kq_ = (Kp) + (size_t)(k0) * (RS); const bf16_t* vq_ = (Vp) + (size_t)(k0) * (RS); const int o0_ = sr * (RS) + sc, o1_ = (32 + sr) * (RS) + sc; \
                         S.st_v0 = ld8(vq_ + o0_); S.st_v1 = ld8(vq_ + o1_); S.st_k0 = ld8(kq_ + o0_); S.st_k1 = ld8(kq_ + o1_); } while (0)
#define SWRITE_HK(bf) do { *(bf16x8*)(K_lds + (bf) * SHM_K + kws) = S.st_k0; *(bf16x8*)(K_lds + (bf) * SHM_K + kws + 32 * 256) = S.st_k1; } while (0)
#define SWRITE_HV(bf) do { *(bf16x8*)(V_lds + (bf) * SHM_V + vst0) = S.st_v0; *(bf16x8*)(V_lds + (bf) * SHM_V + vst1) = S.st_v1; } while (0)
#define SWRITE_H(bf) do { SWRITE_HV(bf); SWRITE_HK(bf); } while (0)
__device__ __forceinline__ void attn_prime(const BlockRef& cur, char* lds, Seam& S) {
    int tid_ = threadIdx.x; asm volatile("" : "+v"(tid_));
    const int tid = tid_, wid = __builtin_amdgcn_readfirstlane(tid >> 6), lane = tid & 63, r32 = lane & 31, hi = lane >> 5;
    const int sr = tid >> 4, sc = (tid & 15) * 8, kws = KSWZ(sr, sc * 2); char* K_lds = lds + 2 * SHM_V;
    const int kb0 = swa_jlo(cur.P0, cur.W) * KVBLK;
    for (int d0 = 0; d0 < 8; ++d0) S.qr[d0] = ld8(cur.Q + (size_t)(wid * QBLK + r32) * cur.rs + d0 * 16 + hi * 8);
    SLOAD_H(cur.K, cur.V, cur.rs, kb0); VMW(); SWRITE_HK(0);
    __syncthreads();
}
__device__ __forceinline__ void attn_block(const BlockRef& cur, const BlockRef& nxt, char* lds, Seam& S) {
    int tid_ = threadIdx.x; asm volatile("" : "+v"(tid_));
    const int tid = tid_, wid = __builtin_amdgcn_readfirstlane(tid >> 6), lane = tid & 63, r32 = lane & 31, hi = lane >> 5;
    const int W = cur.W, skv = cur.skv, RS = cur.rs;
    const int j_lo = swa_jlo(cur.P0, W);
    int j_hi = (cur.P0 + QB - 1) / KVBLK + 1; if (j_hi > skv / KVBLK) j_hi = skv / KVBLK;
    const int NT = j_hi - j_lo;
    const int kbn = swa_jlo(nxt.P0, nxt.W) * KVBLK;
    const int qlo = cur.P0 + wid * QBLK, qm = qlo + r32 - 4 * hi;
    char* V_lds = lds; char* K_lds = lds + 2 * SHM_V;
    float* ws = (float*)(lds + 2 * SHM_V + 2 * SHM_K) + wid * 64; float* li_l = ws, * al_l = ws + 32;
    float m_reg = -1e30f, l_reg = 0; f32x16 o[4] = {};
    const int sr = tid >> 4, sc = (tid & 15) * 8, vst0 = v_st(sr, sc), vst1 = v_st(32 + sr, sc), kws = KSWZ(sr, sc * 2);
    const int vb0 = (int)(uintptr_t)V_lds + v_rd_base(lane);
    const bf16_t* Kh = cur.K; const bf16_t* Vh = cur.V;
#define RESC(a) do { if (__any((a) < 1.f)) { if (hi == 0) al_l[r32] = (a); asm volatile("s_waitcnt lgkmcnt(0)" ::: "memory");              \
                     for (int d_ = 0; d_ < 4; ++d_) for (int r = 0; r < 16; ++r) o[d_][r] *= al_l[crow(r, hi)]; } } while (0)
#define KBASE(t) ((j_lo + (t)) * KVBLK)
#define MASKT(P0_, P1_, t) do { const int kb_ = KBASE(t); if (kb_ + KVBLK - 1 > qlo || kb_ <= qlo + QBLK - 1 - W) mask_tile(P0_, P1_, qm - kb_, (unsigned)W); } while (0)
    constexpr int NQL = 8;
#define SEAM_K0() do { VMWN(NQL); SWRITE_HK(0); SBAR(); } while (0)
    f32x16 pA0, pA1, pB0, pB1; float mnA, mnB, alA, alB; bf16x8 pa0, pa1, pa2, pa3;
    SWRITE_HV(0); SBAR();
    if (NT > 1) { SLOAD_H(Kh, Vh, RS, KBASE(1)); }
    SBAR(); qkt<0>(pA0, pA1, K_lds, r32, hi, S.qr);
    MASKT(pA0, pA1, 0); partialSM(pA0, pA1, m_reg, mnA, alA);
    if (NT > 1) { VMW(); SWRITE_H(1); }
    __syncthreads();
#define HALF_STEP(PX0, PX1, mnX, alX, PY0, PY1, alY, t, KB, VB, SB) do {                                                      \
        SBAR(); qkt<KB>(PX0, PX1, K_lds, r32, hi, S.qr);                                                                      \
        finishSM(PY0, PY1, alY, l_reg, pa0, pa1, pa2, pa3); SBAR();                                                           \
        if ((t) + 1 < NT) { SLOAD_H(Kh, Vh, RS, KBASE((t) + 1)); SBAR(); }                                                    \
        pv_tile<VB>(o, vb0, pa0, pa1, pa2, pa3); MASKT(PX0, PX1, (t)); partialSM(PX0, PX1, m_reg, mnX, alX);                  \
        __syncthreads();                                                                                                      \
        if ((t) + 1 < NT) { VMW(); SWRITE_H(SB); }                                                                            \
        RESC(alX); __syncthreads(); } while (0)
    for (int t = 1; t + 1 < NT; t += 2) {
        HALF_STEP(pB0, pB1, mnB, alB, pA0, pA1, alA, t, 1, 0, 0);
        HALF_STEP(pA0, pA1, mnA, alA, pB0, pB1, alB, t + 1, 0, 1, 1);
    }
    const bool even = (NT & 1) == 0;
    if (even) { SBAR(); qkt<1>(pB0, pB1, K_lds, r32, hi, S.qr); SBAR(); }
    SLOAD_H(nxt.K, nxt.V, nxt.rs, kbn); SBAR();
#pragma unroll
    for (int d0 = 0; d0 < 8; ++d0) S.qr[d0] = ld8(nxt.Q + (size_t)(wid * QBLK + r32) * nxt.rs + d0 * 16 + hi * 8);
    SBAR();
    finishSM(pA0, pA1, alA, l_reg, pa0, pa1, pa2, pa3); SBAR();
    pv_tile<0>(o, vb0, pa0, pa1, pa2, pa3);
    if (even) { MASKT(pB0, pB1, NT - 1); partialSM(pB0, pB1, m_reg, mnB, alB); __syncthreads(); RESC(alB);
        finishSM(pB0, pB1, alB, l_reg, pa0, pa1, pa2, pa3); SBAR(); pv_tile<1>(o, vb0, pa0, pa1, pa2, pa3); }
    SBAR(); SEAM_K0();
    if (hi == 0) li_l[r32] = l_reg; asm volatile("s_waitcnt lgkmcnt(0)" ::: "memory");
    if (cur.LSE && hi == 0) cur.LSE[(size_t)(wid * QBLK + r32) * cur.ls] = m_reg * SCALE + __logf(l_reg);
    float rli[16];
#pragma unroll
    for (int r = 0; r < 16; ++r) rli[r] = __builtin_amdgcn_rcpf(li_l[crow(r, hi)]);
    bf16_t* Ow = cur.O + (size_t)(wid * QBLK) * cur.os;
#pragma unroll
    for (int r = 0; r < 16; ++r) { const int orow = crow(r, hi);
#pragma unroll
        for (int d0 = 0; d0 < 4; ++d0) { const float v = o[d0][r] * rli[r];
            const float vn = __shfl_xor(v, 1);
            if ((r32 & 1) == 0) *(unsigned*)(Ow + (size_t)orow * cur.os + d0 * 32 + r32) = cvtpk(v, vn); } }
    __syncthreads();
#undef RESC
#undef KBASE
#undef MASKT
#undef SEAM_K0
#undef HALF_STEP
}

struct WideRef { const bf16_t* Q; const bf16_t* K; const bf16_t* V; bf16_t* O; int rs, os, P0; };
constexpr int WIDE_K_OFF = 98304, WIDE_WS_OFF = 131072, WIDE_LDS_BYTES = WIDE_WS_OFF + NW * 64 * 4;
#define ATT_LAS __attribute__((address_space(3)))
__device__ __forceinline__ void attn_wide_block(const WideRef& cur, char* lds, ATT_LAS unsigned char* ldsl) {
    int tid_ = threadIdx.x; asm volatile("" : "+v"(tid_));
    const int tid = tid_, wid = __builtin_amdgcn_readfirstlane(tid >> 6), lane = tid & 63, r32 = lane & 31, hi = lane >> 5;
    const bool grpB = wid >= 4;
    const int RS = cur.rs;
    const int NT = cur.P0 / KVBLK + QB / KVBLK;
    const int qlo = cur.P0 + wid * QBLK, qm = qlo + r32 - 4 * hi;
    char* V_lds = lds; char* K_lds = lds + WIDE_K_OFF;
    float* ws = (float*)(lds + WIDE_WS_OFF) + wid * 64; float* li_l = ws, * al_l = ws + 32;
    const int vb0 = (int)(uintptr_t)V_lds + v_rd_base(lane);
    const int L = wid * 1024 + lane * 16;
    const int krow = L >> 8, kcol = ((L & 255) ^ ((krow & 7) << 4)) >> 1;
    const int vsub = L >> 9, vkk = (vsub >> 2) * 8 + ((L & 511) >> 6), vcol = (vsub & 3) * 32 + ((L & 63) >> 1);
    const int vkey = (vkk & ~0xC) | ((vkk & 4) << 1) | ((vkk & 8) >> 1);
    const unsigned offK = (unsigned)(krow * RS + kcol) * 2u, offV = (unsigned)(vkey * RS + vcol) * 2u;
    const size_t half32 = (size_t)32 * RS * 2;
    bf16x8 qr[8];
#pragma unroll
    for (int d0 = 0; d0 < 8; ++d0) qr[d0] = ld8(cur.Q + (size_t)(wid * QBLK + r32) * RS + d0 * 16 + hi * 8);
#define WDMA1(gp, ldsoff) __builtin_amdgcn_global_load_lds((const unsigned*)(gp), (ATT_LAS unsigned*)(ldsl + (ldsoff) + wid * 1024), 16, 0, 0)
#define WDMA(k0, kb, vb) do { const char* kq_ = (const char*)(cur.K + (size_t)(k0) * RS); const char* vq_ = (const char*)(cur.V + (size_t)(k0) * RS); \
        const int ko_ = WIDE_K_OFF + (kb) * SHM_K, vo_ = (vb) * 32768; \
        WDMA1(kq_ + offK, ko_); WDMA1(kq_ + half32 + offK, ko_ + 8192); \
        WDMA1(vq_ + offV, vo_); WDMA1(vq_ + half32 + offV, vo_ + 8192); \
        WDMA1(vq_ + 256 + offV, vo_ + 16384); WDMA1(vq_ + 256 + half32 + offV, vo_ + 16384 + 8192); } while (0)
    WDMA(0, 0, 0); asm volatile("s_waitcnt vmcnt(0)" ::: "memory");
    __syncthreads();
    float m_reg = -1e30f, l_reg = 0; f32x16 o[8] = {};
    bf16x8 pa0 = {}, pa1 = {}, pa2 = {}, pa3 = {};
    int v3 = 0;
#define WQK(t) do { f32x16 p0, p1; float mn, al; \
        qkt<0>(p0, p1, K_lds + ((t) & 1) * SHM_K, r32, hi, qr); \
        { const int kb_ = (t) * KVBLK; if (kb_ + KVBLK - 1 > qlo) mask_tile(p0, p1, qm - kb_, 1u << 30); } \
        partialSM(p0, p1, m_reg, mn, al); finishSM(p0, p1, al, l_reg, pa0, pa1, pa2, pa3); SBAR(); \
        if (__any(al < 1.f)) { if (hi == 0) al_l[r32] = al; asm volatile("s_waitcnt lgkmcnt(0)" ::: "memory"); \
            _Pragma("unroll") for (int d_ = 0; d_ < 8; ++d_) _Pragma("unroll") for (int r = 0; r < 16; ++r) o[d_][r] *= al_l[crow(r, hi)]; } } while (0)
#define WPV(vbuf) do { const int vbt_ = vb0 + (vbuf) * 32768; pv_tile<0, 16384>(o, vbt_, pa0, pa1, pa2, pa3); pv_tile<1, 16384>(o + 4, vbt_, pa0, pa1, pa2, pa3); SBAR(); } while (0)
    for (int t = 0; t < NT; ++t) {
        const int v3n = v3 == 2 ? 0 : v3 + 1, v3p = v3 == 0 ? 2 : v3 - 1;
        if (t + 1 < NT) { WDMA((t + 1) * KVBLK, (t + 1) & 1, v3n); } SBAR();
        if (grpB && t > 0) { WPV(v3p); }
        WQK(t);
        if (!grpB) { WPV(v3); }
        asm volatile("s_waitcnt vmcnt(0)" ::: "memory");
        __syncthreads();
        v3 = v3n;
    }
    if (grpB) { const int v3p = v3 == 0 ? 2 : v3 - 1; WPV(v3p); }
#undef WQK
#undef WPV
#undef WDMA
#undef WDMA1
    if (hi == 0) li_l[r32] = l_reg; asm volatile("s_waitcnt lgkmcnt(0)" ::: "memory");
    float rli[16];
#pragma unroll
    for (int r = 0; r < 16; ++r) rli[r] = __builtin_amdgcn_rcpf(li_l[crow(r, hi)]);
    __syncthreads();
    char* stg = lds + wid * 16896;
#pragma unroll
    for (int r = 0; r < 16; ++r) { const int orow = crow(r, hi);
#pragma unroll
        for (int d0 = 0; d0 < 8; ++d0) { const float v = o[d0][r] * rli[r];
            const float vn = __int_as_float(__builtin_amdgcn_update_dpp(0, __float_as_int(v), 0xB1, 0xF, 0xF, false));
            if ((r32 & 1) == 0) *(unsigned*)(stg + orow * 528 + (d0 * 32 + r32) * 2) = cvtpk(v, vn); } }
    asm volatile("s_waitcnt lgkmcnt(0)" ::: "memory");
    bf16_t* Ow = cur.O + (size_t)(wid * QBLK) * cur.os;
#pragma unroll
    for (int i2 = 0; i2 < 16; ++i2) { const int row = 2 * i2 + hi;
        const u32x4 w = *(const u32x4*)(stg + row * 528 + r32 * 16);
        *(u32x4*)(Ow + (size_t)row * cur.os + r32 * 8) = w; }
    __syncthreads();
}
#undef VMW
#undef VMWN
#undef SLOAD_H
#undef SWRITE_HK
#undef SWRITE_HV
#undef SWRITE_H
}

#define GAS __attribute__((address_space(1)))
#define LAS __attribute__((address_space(3)))
typedef unsigned short bf16;
typedef unsigned v4u __attribute__((ext_vector_type(4)));
typedef unsigned v2u __attribute__((ext_vector_type(2)));
typedef float f32x4 __attribute__((ext_vector_type(4)));
#define LDS_WAIT() asm volatile("s_waitcnt lgkmcnt(0)" ::: "memory")
__device__ __forceinline__ unsigned f2bf(float f) { unsigned u = __builtin_bit_cast(unsigned, f); return (u + 0x7fffu + ((u >> 16) & 1u)) >> 16; }
__device__ __forceinline__ unsigned pk2(float lo, float hi) { return f2bf(lo) | (f2bf(hi) << 16); }
__device__ __forceinline__ float bflo(unsigned w) { return __uint_as_float(w << 16); }
__device__ __forceinline__ float bfhi(unsigned w) { return __uint_as_float(w & 0xffff0000u); }

#define XB_TMO      128
#define XB_XCNT(j)  (256  + 64 * (j))
#define XB_XSUB(j)  (1280 + 64 * (j))
#define XB_XGEN(j)  (2304 + 64 * (j))
#define XB_TOP      3328
#define XB_TOPGEN   3392
#define XCD_BAR_WORDS 3456
#define XB_SPIN_CAP (1u << 18)

__device__ __forceinline__ unsigned xb_ld(unsigned* p)              { return __hip_atomic_load(p, __ATOMIC_RELAXED, __HIP_MEMORY_SCOPE_AGENT); }
__device__ __forceinline__ unsigned xb_add(unsigned* p, unsigned v) { return __hip_atomic_fetch_add(p, v, __ATOMIC_RELAXED, __HIP_MEMORY_SCOPE_AGENT); }
__device__ __forceinline__ unsigned xb_xcc_id() { return (unsigned)__builtin_amdgcn_s_getreg((3 << 11) | 20) & 0xFu; }
#define XB_SPIN(cond, bar) do { unsigned _sp = 0; while (cond) { __builtin_amdgcn_s_sleep(1); \
    if ((++_sp & 255u) == 0u) { if (xb_ld(&(bar)[XB_TMO])) break; if (_sp > XB_SPIN_CAP) { atomicAdd(&(bar)[XB_TMO], 1u); break; } } } } while (0)

struct XcdBarrier {
    unsigned* bar; unsigned x;
    volatile LAS unsigned* st;
};

__device__ __forceinline__ XcdBarrier xcd_barrier_post(unsigned* bar, volatile LAS unsigned* st) {
    XcdBarrier b; b.bar = bar; b.x = xb_xcc_id(); b.st = st;
    if (threadIdx.x == 0) (void)xb_add(&bar[XB_XCNT(b.x)], 1u);
    return b;
}
__device__ __forceinline__ void xcd_barrier_complete(unsigned* bar, unsigned x, unsigned& nloc, unsigned& nx) {
    const unsigned G = gridDim.x * gridDim.y * gridDim.z;
    unsigned sum, cnt, mine, sp = 0u;
    for (;;) {
        sum = 0u; cnt = 0u; mine = 0u;
#pragma unroll
        for (unsigned j = 0; j < 16; ++j) { const unsigned c = xb_ld(&bar[XB_XCNT(j)]); sum += c; cnt += (c > 0u) ? 1u : 0u; mine = (j == x) ? c : mine; }
        if (sum == G) break;
        __builtin_amdgcn_s_sleep(1);
        if ((++sp & 255u) == 0u) { if (xb_ld(&bar[XB_TMO])) break; if (sp > XB_SPIN_CAP) { atomicAdd(&bar[XB_TMO], 1u); break; } }
    }
    nloc = mine > 0u ? mine : 1u; nx = cnt > 0u ? cnt : 1u;
}

__device__ __forceinline__ void xcd_barrier(const XcdBarrier& b) {
    asm volatile("s_waitcnt vmcnt(0)" ::: "memory");
    __syncthreads();
    if (threadIdx.x == 0) {
        unsigned* bar = b.bar;
        __builtin_amdgcn_s_waitcnt(0);
        unsigned nloc = b.st[0], nx = b.st[1];
        if (nloc == 0u) { xcd_barrier_complete(bar, b.x, nloc, nx); b.st[0] = nloc; b.st[1] = nx; }
        const unsigned old = xb_add(&bar[XB_XSUB(b.x)], 1u);
        const unsigned gen = old / nloc;
        if (old + 1u == (gen + 1u) * nloc) {
            __builtin_amdgcn_fence(__ATOMIC_RELEASE, "agent");
            asm volatile("s_waitcnt vmcnt(0)" ::: "memory");
            const unsigned og = xb_add(&bar[XB_TOP], 1u);
            const unsigned tg = og / nx;
            if (og + 1u == (tg + 1u) * nx) xb_add(&bar[XB_TOPGEN], 1u);
            else XB_SPIN(xb_ld(&bar[XB_TOPGEN]) == tg, bar);
            __builtin_amdgcn_fence(__ATOMIC_ACQUIRE, "agent");
            xb_add(&bar[XB_XGEN(b.x)], 1u);
            asm volatile("s_waitcnt vmcnt(0)" ::: "memory");
        } else {
            XB_SPIN(xb_ld(&bar[XB_XGEN(b.x)]) == gen, bar);
            __builtin_amdgcn_fence(__ATOMIC_ACQUIRE, "agent");
            asm volatile("s_waitcnt vmcnt(0)" ::: "memory");
        }
    }
    __syncthreads();
}
constexpr int NB = 4, SEQ = 4096, DM = 2048, M = NB * SEQ, DFF = 5632, NQKV = 7680, NGATE = 4096, DIN = NQKV + NGATE;
constexpr int NWAVES = 8;
constexpr float RMS_EPS = 1e-6f;
constexpr float LAM_INIT = 0.2f;
constexpr size_t MiB = 1u << 20;
constexpr size_t WS_QKV = 0, WS_GATES = 240 * MiB;
constexpr size_t WS_W1GU = 0, WS_W1D = 44 * MiB, WS_HID = 66 * MiB;
constexpr size_t WS_XB = 368 * MiB;
constexpr size_t WS_WIN = 432 * MiB;
constexpr size_t WS_ODIL_RAW = 432 * MiB;
constexpr size_t WS_LSE = 480 * MiB;
constexpr size_t WS_SS = 481 * MiB;
constexpr size_t WS_ROPE = 482 * MiB;
constexpr size_t WS_WOUT = 484 * MiB, WS_WDIL = 492 * MiB, WS_WDIFF = 494 * MiB;
constexpr size_t WS_W2GU = 0, WS_W2D = 44 * MiB, WS_ODIL = 66 * MiB, WS_ODIFF = 82 * MiB, WS_Y = 114 * MiB;
constexpr size_t WS_HID2 = 66 * MiB;
constexpr size_t WS_BAR = 498 * MiB, WS_BAR_BYTES = 16384;
constexpr size_t WS_END = 499 * MiB;
constexpr int LDS_MISC = 139264, LDS_BYTES = LDS_MISC + 256;

__device__ __forceinline__ float wave_sum(float v) {
#pragma unroll
    for (int o = 1; o < 64; o <<= 1) v += __shfl_xor(v, o);
    return v;
}
__device__ __forceinline__ unsigned cvtpk2(float lo, float hi) { unsigned r; asm volatile("v_cvt_pk_bf16_f32 %0, %1, %2" : "=v"(r) : "v"(lo), "v"(hi)); return r; }
__device__ __forceinline__ void transpose_mat(const float* W, int K, int N, const float* gain, bf16* WT, int mode, int gw, int NGW, int lane, int& ibase, LAS float* scr, int blk = 0, int ldk = 0, int koff = 0) {
    const int nkb = K / 64, nit = nkb * (N / 64);
    const int it0 = (gw - ibase % NGW + NGW) % NGW; ibase += nit;
    const int ln = (lane & 15) * 4, lk = lane >> 4, c = lane & 7, ns = lane >> 3;
    for (int it = it0; it < nit; it += NGW) {
        const int nb = it / nkb, kb = it - nb * nkb, k0 = kb * 64, n0 = nb * 64;
        const float* src = W + (size_t)(k0 + lk) * N + n0 + ln;
        f32x4 v[16];
#pragma unroll
        for (int i = 0; i < 16; ++i) v[i] = __builtin_nontemporal_load((const f32x4*)(src + (size_t)(4 * i) * N));
        if (gain) {
#pragma unroll
            for (int i = 0; i < 16; ++i) v[i] = v[i] * gain[k0 + 4 * i + lk];
        }
#pragma unroll
        for (int i = 0; i < 16; ++i) { LAS float* d = scr + (4 * i + lk) * 65 + ln; d[0] = v[i][0]; d[1] = v[i][1]; d[2] = v[i][2]; d[3] = v[i][3]; }
        LDS_WAIT(); asm volatile("" ::: "memory");
#pragma unroll
        for (int jj = 0; jj < 8; ++jj) { const int nl = ns + 8 * jj, n = n0 + nl; const LAS float* s = scr + (8 * c) * 65 + nl;
            const int row = mode == 0 ? n : ((n >> 7) * 256 + (mode == 2 ? 128 : 0) + (n & 127));
            v4u o; o.x = cvtpk2(s[0 * 65], s[1 * 65]); o.y = cvtpk2(s[2 * 65], s[3 * 65]); o.z = cvtpk2(s[4 * 65], s[5 * 65]); o.w = cvtpk2(s[6 * 65], s[7 * 65]);
            bf16* dst = blk ? WT + (size_t)(k0 >> 6) * ((size_t)blk * 64) + (size_t)row * 64 + 8 * c : WT + (size_t)row * (ldk ? ldk : K) + koff + k0 + 8 * c;
            *(v4u*)dst = o; }
        LDS_WAIT(); asm volatile("" ::: "memory");
    }
}

#ifndef PG_ALIGN_BIG
#define PG_ALIGN_BIG true
#endif
struct Args { const float* in[24]; float* out; unsigned char* ws; int ph_lo, ph_hi; };
constexpr int NPHASE = 11;

__device__ __forceinline__ att::BlockRef attn_decode(int s, int w, int G, int nd, bf16* qkv, bf16* odiff_raw, bf16* odil_raw, float* lse) {
    att::BlockRef r;
    if (s < 2 * nd) {
        const int item = w + (s >> 1) * G, pass = s & 1, head = item >> 3, y = item & 7, qb = pass ? 15 - y : y;
        const int vh = head & 1, comp = (head >> 1) & 1, h = (head >> 2) & 3, b = head >> 4;
        bf16* base = qkv + (size_t)(b * SEQ) * NQKV;
        r.Q = base + 4608 + h * 256 + comp * 128 + (size_t)(qb * 256) * NQKV;
        r.K = base + 5632 + h * 256 + comp * 128;
        r.V = base + 6656 + h * 256 + vh * 128;
        r.O = odiff_raw + (size_t)comp * ((size_t)M * 1024) + (size_t)(b * SEQ + qb * 256) * 1024 + h * 256 + vh * 128;
        r.LSE = nullptr; r.rs = NQKV; r.os = 1024; r.ls = 0; r.P0 = qb * 256; r.W = 1 << 30; r.skv = SEQ;
    } else {
        const int blk = w + (s - 2 * nd) * G, g = blk >> 8, rem = blk & 255;
        const int dil = g == 0 ? 1 : (g == 1 ? 4 : 16), L = SEQ / dil, nqb = L / 256;
        const int qb = rem % nqb; int t = rem / nqb; const int c = t % dil; t /= dil; const int h = t & 3, b = t >> 2;
        const size_t tok0 = (size_t)b * SEQ + c;
        bf16* base = qkv + tok0 * NQKV + g * 512 + h * 128;
        r.Q = base + (size_t)(qb * 256) * ((size_t)dil * NQKV);
        r.K = base + 1536;
        r.V = base + 3072;
        r.O = odil_raw + (size_t)g * ((size_t)M * 512) + tok0 * 512 + h * 128 + (size_t)(qb * 256) * ((size_t)dil * 512);
        r.LSE = lse + (size_t)g * ((size_t)M * 4) + tok0 * 4 + h + (size_t)(qb * 256) * ((size_t)dil * 4);
        r.rs = dil * NQKV; r.os = dil * 512; r.ls = dil * 4; r.P0 = qb * 256; r.W = 129; r.skv = L;
    }
    return r;
}

__global__ void __launch_bounds__(NWAVES * 64, 2) layer_fwd(Args args) {
    extern __shared__ __attribute__((aligned(16))) unsigned char lds[];
    const int wave = __builtin_amdgcn_readfirstlane((int)threadIdx.x >> 6);
#define PHASE_TID() int tid_ = threadIdx.x; asm volatile("" : "+v"(tid_)); const int tid = tid_, lane = tid & 63; (void)lane
    const int G = gridDim.x, bx = blockIdx.x;
    const int vcu = (G % 8 == 0) ? (bx % 8) * (G / 8) + bx / 8 : bx;
    const int gw = vcu * NWAVES + wave, NGW = G * NWAVES;
    const int NTHR = G * NWAVES * 64;
    unsigned char* ws = args.ws;
    LAS unsigned char* ldsl = (LAS unsigned char*)lds;
    const int lo = args.ph_lo, hi = args.ph_hi;
#ifndef PHASE_MASK
#define PHASE_MASK 0x7ff
#endif
#define IN(k) (((PHASE_MASK >> (k)) & 1) && lo <= (k) && (k) < hi)
    volatile LAS unsigned* MISC = (volatile LAS unsigned*)(ldsl + LDS_MISC);
    if (threadIdx.x < 64) MISC[threadIdx.x] = 0u;
    __syncthreads();
    XcdBarrier bar = xcd_barrier_post((unsigned*)(ws + WS_BAR), MISC + 8);
#define SEAM(k) do { if (IN(k) && IN((k) + 1)) { if ((k) == 0) { asm volatile("s_waitcnt vmcnt(0)" ::: "memory"); cg::this_grid().sync(); } else xcd_barrier(bar); } STAMP(k); } while (0)
#ifndef PROBE_MASK
#define PROBE_MASK 0
#endif
#if PROBE_MASK
    unsigned long long t_prev = __builtin_amdgcn_s_memrealtime(), t_acc = 0; unsigned kl_save = 0; (void)kl_save;
#define STAMP(k) do { const unsigned long long t_now = __builtin_amdgcn_s_memrealtime(); if ((PROBE_MASK >> (k)) & 1) t_acc += t_now - t_prev; t_prev = t_now; } while (0)
#else
#define STAMP(k) do { } while (0)
#endif
    const float* x = args.in[0]; float* out = args.out;
    bf16* XB = (bf16*)(ws + WS_XB); bf16* HID = (bf16*)(ws + WS_HID); bf16* QKV = (bf16*)(ws + WS_QKV); bf16* GATES = (bf16*)(ws + WS_GATES);
    float* SS1 = (float*)(ws + WS_SS); float* SS2 = SS1 + M; float* SS3 = SS2 + M;
    float* COS = (float*)(ws + WS_ROPE); float* SIN = COS + (size_t)M * 16;
    float* LSE = (float*)(ws + WS_LSE);
    bf16* W2GU = (bf16*)out + (size_t)32 * 1024 * 1024;
    const int nwg3 = (M / 256) * (DIN / 256), rounds3 = (nwg3 + G - 1) / G, first_idle3 = nwg3 - (rounds3 - 1) * G;
    const bool w2gu_in_p3 = first_idle3 < G;
    bf16* ODIFF_RAW = (bf16*)out;     bf16* ODIL_RAW = (bf16*)(ws + WS_ODIL_RAW);
    bf16* ODIL = (bf16*)(ws + WS_ODIL); bf16* ODIFF = (bf16*)(ws + WS_ODIFF); bf16* Y = (bf16*)(ws + WS_Y);

    if (IN(0)) {
        PHASE_TID(); const int gtid = bx * (NWAVES * 64) + tid;
        int ibase = 0; LAS float* scr = (LAS float*)(ldsl + wave * 16640);
        transpose_mat(args.in[3], DM, DFF, args.in[2], (bf16*)(ws + WS_W1GU), 1, gw, NGW, lane, ibase, scr);
        transpose_mat(args.in[4], DM, DFF, args.in[2], (bf16*)(ws + WS_W1GU), 2, gw, NGW, lane, ibase, scr);
        transpose_mat(args.in[5], DFF, DM, nullptr, (bf16*)(ws + WS_W1D), 0, gw, NGW, lane, ibase, scr);
        transpose_mat(args.in[7], DM, DIN, args.in[6], (bf16*)(ws + WS_WIN), 0, gw, NGW, lane, ibase, scr);
        transpose_mat(args.in[17], 512, DM, nullptr, (bf16*)(ws + WS_WDIL), 0, gw, NGW, lane, ibase, scr, 0, 1536, 0);
        transpose_mat(args.in[18], 1024, DM, nullptr, (bf16*)(ws + WS_WDIL), 0, gw, NGW, lane, ibase, scr, 0, 1536, 512);
        transpose_mat(args.in[19], DM, DM, nullptr, (bf16*)(ws + WS_WOUT), 0, gw, NGW, lane, ibase, scr);
        for (int m = gw; m < M; m += NGW) {
            const f32x4* xr = (const f32x4*)(x + (size_t)m * DM) + lane; f32x4 v[8]; float s = 0.f;
#pragma unroll
            for (int j = 0; j < 8; ++j) { v[j] = __builtin_nontemporal_load(xr + 64 * j); s += (v[j].x * v[j].x + v[j].y * v[j].y) + (v[j].z * v[j].z + v[j].w * v[j].w); }
            s = wave_sum(s); if (lane == 0) SS1[m] = s;
            v2u* o8 = (v2u*)(XB + (size_t)m * DM) + lane;
#pragma unroll
            for (int j = 0; j < 8; ++j) { v2u w; w.x = pk2(v[j].x, v[j].y); w.y = pk2(v[j].z, v[j].w); o8[64 * j] = w; }
        }
        for (int i = gtid; i < 2 * M; i += NTHR) SS2[i] = 0.f;
        const int* pos = (const int*)args.in[1];
        for (int idx = gtid; idx < M * 16; idx += NTHR) { const int t = idx >> 4, i = idx & 15;
            const float inv = __builtin_amdgcn_exp2f((float)i * (-1.0f / 16.0f) * 18.931568569324174f);
            const float ang = (float)pos[t] * inv;
            const double rev = (double)ang * 0.15915494309189535; const float fr = (float)(rev - __builtin_rint(rev));
            COS[idx] = __builtin_amdgcn_cosf(fr); SIN[idx] = __builtin_amdgcn_sinf(fr); }
    }
    SEAM(0);
#ifdef PROBE_KLOOP
    if (PROBE_KLOOP == 1 && threadIdx.x == 0) MISC[16] = 0u;
#endif
    if (IN(1)) {
        pg8::Gemm g{XB, (bf16*)(ws + WS_W1GU), M, 2 * DFF, DM}; pg8::StaticOrder So; So.init(M, 2 * DFF, G, bx);
        pg8::EpiSwiglu<false> E{HID, DFF, SS1, M};
        pg8::gemm_phase<pg8::EpiSwiglu<false>, pg8::StaticOrder, PG_ALIGN_BIG, true>(ldsl, g, So, E);
    }
    SEAM(1);
#ifdef PROBE_KLOOP
    if (PROBE_KLOOP == 1 && threadIdx.x == 0) { kl_save = MISC[16]; }
#endif
    if (IN(2)) {
        pg8::Gemm g{HID, (bf16*)(ws + WS_W1D), M, DM, DFF}; pg8::StaticOrder So; So.init(M, DM, G, bx, 4);
        pg8::EpiResid<true, false, false> E{x, nullptr, XB, SS2, 0.5f, DM};
        pg8::gemm_phase<pg8::EpiResid<true, false, false>, pg8::StaticOrder, true, true>(ldsl, g, So, E);
    }
    SEAM(2);
    if (IN(3)) {
        pg8::Gemm g{XB, (bf16*)(ws + WS_WIN), M, DIN, DM}; pg8::StaticOrder So; So.init(M, DIN, G, bx);
        pg8::EpiProj E{QKV, NQKV, GATES, NGATE, NQKV / 256, SS2, args.in[8], args.in[9], args.in[10], args.in[11], COS, SIN, (LAS float*)(ldsl + 131072)};
        pg8::gemm_phase<pg8::EpiProj, pg8::StaticOrder, true, true>(ldsl, g, So, E);
        if (w2gu_in_p3 && bx >= first_idle3) {
            PHASE_TID(); const int gwi = (bx - first_idle3) * NWAVES + wave, NGWI = (G - first_idle3) * NWAVES; int ibase = 0; LAS float* scr = (LAS float*)(ldsl + wave * 16640);
            transpose_mat(args.in[21], DM, DFF, args.in[20], W2GU, 1, gwi, NGWI, lane, ibase, scr);
            transpose_mat(args.in[22], DM, DFF, args.in[20], W2GU, 2, gwi, NGWI, lane, ibase, scr);
        }
    }
    SEAM(3);
    if (IN(5)) {
        const int w = vcu;
        for (int i = w; i < 256; i += G) {
            const int head = i >> 3, y = i & 7, comp = head & 1, h = (head >> 1) & 3, b = head >> 3;
            bf16* base = QKV + (size_t)(b * SEQ) * NQKV;
            for (int pass = 0; pass < 2; ++pass) { const int qb = pass ? y : 15 - y;
                att::WideRef r; r.Q = base + 4608 + h * 256 + comp * 128 + (size_t)(qb * 256) * NQKV; r.K = base + 5632 + h * 256 + comp * 128; r.V = base + 6656 + h * 256;
                r.O = ODIFF_RAW + (size_t)comp * ((size_t)M * 1024) + (size_t)(b * SEQ + qb * 256) * 1024 + h * 256; r.rs = NQKV; r.os = 1024; r.P0 = qb * 256;
                att::attn_wide_block(r, (char*)lds, ldsl); }
        }
        const int nd = 0, ndl = w < 768 ? (768 - w + G - 1) / G : 0, total = ndl;
        if (total > 0) {
            att::Seam S;
            { const att::BlockRef c0 = attn_decode(0, w, G, nd, QKV, ODIFF_RAW, ODIL_RAW, LSE); att::attn_prime(c0, (char*)lds, S); }
            for (int s = 0; s < total; ++s) {
                const att::BlockRef cur = attn_decode(s, w, G, nd, QKV, ODIFF_RAW, ODIL_RAW, LSE);
                const att::BlockRef nxt = attn_decode(s + 1 < total ? s + 1 : s, w, G, nd, QKV, ODIFF_RAW, ODIL_RAW, LSE);
                att::attn_block(cur, nxt, (char*)lds, S);
            }
        }
    }
    SEAM(5);
    if (IN(6)) {
        PHASE_TID();
        int ibase = 0; LAS float* scr = (LAS float*)(ldsl + wave * 16640);
        if (!w2gu_in_p3) {
            transpose_mat(args.in[21], DM, DFF, args.in[20], W2GU, 1, gw, NGW, lane, ibase, scr);
            transpose_mat(args.in[22], DM, DFF, args.in[20], W2GU, 2, gw, NGW, lane, ibase, scr);
        }
        transpose_mat(args.in[23], DFF, DM, nullptr, (bf16*)(ws + WS_W2D), 0, gw, NGW, lane, ibase, scr);
        float lam;
        { const float a = args.in[12][lane] * args.in[13][lane] + args.in[12][lane + 64] * args.in[13][lane + 64];
          const float b = args.in[14][lane] * args.in[15][lane] + args.in[14][lane + 64] * args.in[15][lane + 64];
          lam = __expf(wave_sum(a)) - __expf(wave_sum(b)) + LAM_INIT; }
        const float* subln = args.in[16];
        for (int t = gw; t < M; t += NGW) {
            {
                const int h = lane >> 4;
                const float l0 = LSE[(size_t)t * 4 + h], l1 = LSE[(size_t)M * 4 + (size_t)t * 4 + h], l2 = LSE[(size_t)M * 8 + (size_t)t * 4 + h];
                const float mx = fmaxf(l0, fmaxf(l1, l2)); const float e0 = __expf(l0 - mx), e1 = __expf(l1 - mx), e2 = __expf(l2 - mx); const float inv = 1.0f / (e0 + e1 + e2);
                const float w0 = e0 * inv, w1 = e1 * inv, w2 = e2 * inv;
                const size_t off = (size_t)t * 512 + lane * 8, offo = (size_t)t * 1536 + lane * 8;
                const v4u a = __builtin_nontemporal_load((const v4u*)(ODIL_RAW + off)), b = __builtin_nontemporal_load((const v4u*)(ODIL_RAW + (size_t)M * 512 + off)), c = __builtin_nontemporal_load((const v4u*)(ODIL_RAW + (size_t)M * 1024 + off));
                v4u o;
                o.x = pk2(w0 * bflo(a.x) + w1 * bflo(b.x) + w2 * bflo(c.x), w0 * bfhi(a.x) + w1 * bfhi(b.x) + w2 * bfhi(c.x));
                o.y = pk2(w0 * bflo(a.y) + w1 * bflo(b.y) + w2 * bflo(c.y), w0 * bfhi(a.y) + w1 * bfhi(b.y) + w2 * bfhi(c.y));
                o.z = pk2(w0 * bflo(a.z) + w1 * bflo(b.z) + w2 * bflo(c.z), w0 * bfhi(a.z) + w1 * bfhi(b.z) + w2 * bfhi(c.z));
                o.w = pk2(w0 * bflo(a.w) + w1 * bflo(b.w) + w2 * bflo(c.w), w0 * bfhi(a.w) + w1 * bfhi(b.w) + w2 * bfhi(c.w));
                *(v4u*)(ODIL + offo) = o;
            }
#pragma unroll
            for (int hh = 0; hh < 2; ++hh) {
                const int l32 = lane & 31;
                const size_t off = (size_t)t * 1024 + (size_t)(hh * 2 + (lane >> 5)) * 256 + l32 * 8;
                const v4u a = __builtin_nontemporal_load((const v4u*)(ODIFF_RAW + off)), b = __builtin_nontemporal_load((const v4u*)(ODIFF_RAW + (size_t)M * 1024 + off));
                float d[8] = {bflo(a.x) - lam * bflo(b.x), bfhi(a.x) - lam * bfhi(b.x), bflo(a.y) - lam * bflo(b.y), bfhi(a.y) - lam * bfhi(b.y),
                              bflo(a.z) - lam * bflo(b.z), bfhi(a.z) - lam * bfhi(b.z), bflo(a.w) - lam * bflo(b.w), bfhi(a.w) - lam * bfhi(b.w)};
                float s = 0.f;
#pragma unroll
                for (int i = 0; i < 8; ++i) s += d[i] * d[i];
                s += __shfl_xor(s, 1); s += __shfl_xor(s, 2); s += __shfl_xor(s, 4); s += __shfl_xor(s, 8); s += __shfl_xor(s, 16);
                const float rs = rsqrtf(s * (1.0f / 256.0f) + RMS_EPS) * (1.0f - LAM_INIT);
                const f32x4 g0 = *(const f32x4*)(subln + l32 * 8), g1 = *(const f32x4*)(subln + l32 * 8 + 4);
                v4u o; o.x = pk2(d[0] * rs * g0[0], d[1] * rs * g0[1]); o.y = pk2(d[2] * rs * g0[2], d[3] * rs * g0[3]);
                o.z = pk2(d[4] * rs * g1[0], d[5] * rs * g1[1]); o.w = pk2(d[6] * rs * g1[2], d[7] * rs * g1[3]);
                *(v4u*)(ODIL + (size_t)t * 1536 + 512 + (size_t)(hh * 2 + (lane >> 5)) * 256 + l32 * 8) = o;
            }
        }
    }
    SEAM(6);
    if (IN(7)) {
        pg8::Gemm g{ODIL, (bf16*)(ws + WS_WDIL), M, DM, 1536}; pg8::StaticOrder So; So.init(M, DM, G, bx, 4);
        pg8::EpiGateMerge E{GATES, NGATE, Y, DM, 512 / 64};
        pg8::gemm_phase<pg8::EpiGateMerge, pg8::StaticOrder, true, true>(ldsl, g, So, E);
    }
    SEAM(7);
    if (IN(8)) {
        pg8::Gemm g{Y, (bf16*)(ws + WS_WOUT), M, DM, DM}; pg8::StaticOrder So; So.init(M, DM, G, bx, 4);
        pg8::EpiResid<false, false> E{XB, nullptr, XB, SS3, 1.0f, DM};
        pg8::gemm_phase<pg8::EpiResid<false, false>, pg8::StaticOrder, true, true>(ldsl, g, So, E);
    }
    SEAM(8);
    if (IN(9)) {
        pg8::Gemm g{XB, W2GU, M, 2 * DFF, DM}; pg8::StaticOrder So; So.init(M, 2 * DFF, G, bx);
        pg8::EpiSwiglu<false> E{(bf16*)(ws + WS_HID2), DFF, SS3, M};
        pg8::gemm_phase<pg8::EpiSwiglu<false>, pg8::StaticOrder, PG_ALIGN_BIG, true>(ldsl, g, So, E);
    }
    SEAM(9);
#ifdef PROBE_KLOOP
    if (PROBE_KLOOP == 10 && threadIdx.x == 0) MISC[16] = 0u;
#endif
    if (IN(10)) {
        pg8::Gemm g{(bf16*)(ws + WS_HID2), (bf16*)(ws + WS_W2D), M, DM, DFF}; pg8::StaticOrder So; So.init(M, DM, G, bx, 4);
        pg8::EpiResid<false, true, false> E{XB, out, nullptr, nullptr, 0.5f, DM};
        pg8::gemm_phase<pg8::EpiResid<false, true, false>, pg8::StaticOrder, true, true>(ldsl, g, So, E);
    }
    STAMP(10);
#ifdef PROBE_KLOOP
    t_acc = 0; if (threadIdx.x == 0) t_acc = (PROBE_KLOOP == 1) ? kl_save : MISC[16];
#endif
#if PROBE_MASK
    if (bx == 0 && threadIdx.x == 0) { const unsigned long long t0 = __builtin_amdgcn_s_memrealtime(); while (__builtin_amdgcn_s_memrealtime() - t0 < t_acc) __builtin_amdgcn_s_sleep(8); }
#endif
#undef IN
#undef SEAM
}

extern "C" void kernel_launch(void* const* d_in, const int* in_sizes, int n_in, void* d_out, int out_size, void* d_ws, size_t ws_size, hipStream_t stream) {
    static int grid = 0;
    if (grid == 0) {
        if (n_in != 24 || in_sizes[0] != M * DM || out_size != M * DM || ws_size < WS_END) {
            fprintf(stderr, "kernel_launch: unexpected shapes (n_in %d, in0 %d, out %d, ws %zu, need %zu)\n", n_in, n_in > 0 ? in_sizes[0] : -1, out_size, ws_size, (size_t)WS_END); grid = -1; return; }
        int dev = 0, cus = 0, per_cu = 0;
        if (hipGetDevice(&dev) != hipSuccess || hipDeviceGetAttribute(&cus, hipDeviceAttributeMultiprocessorCount, dev) != hipSuccess) { grid = -1; return; }
        if (hipFuncSetAttribute((const void*)layer_fwd, hipFuncAttributeMaxDynamicSharedMemorySize, LDS_BYTES) != hipSuccess) { fprintf(stderr, "kernel_launch: hipFuncSetAttribute failed\n"); grid = -1; return; }
        if (hipOccupancyMaxActiveBlocksPerMultiprocessor(&per_cu, (const void*)layer_fwd, NWAVES * 64, LDS_BYTES) != hipSuccess || per_cu < 1) { fprintf(stderr, "kernel_launch: occupancy query says %d\n", per_cu); per_cu = 1; }
        (void)hipGetLastError();
        grid = cus * per_cu;
    }
    if (grid < 0) return;
    if (hipMemsetAsync((char*)d_ws + WS_BAR, 0, WS_BAR_BYTES, stream) != hipSuccess) { fprintf(stderr, "kernel_launch: memset of the barrier words failed\n"); return; }
    Args a{};
    for (int i = 0; i < 24; ++i) a.in[i] = (const float*)d_in[i];
    a.out = (float*)d_out; a.ws = (unsigned char*)d_ws;
#if ONE_LAUNCH
    a.ph_lo = 0; a.ph_hi = NPHASE;
    void* kargs[] = {&a};
    hipError_t e = hipLaunchCooperativeKernel((const void*)layer_fwd, dim3(grid), dim3(NWAVES * 64), kargs, LDS_BYTES, stream);
    if (e != hipSuccess) fprintf(stderr, "kernel_launch: cooperative launch failed: %s (grid %d)\n", hipGetErrorString(e), grid);
#else
    for (int p = 0; p < NPHASE; ++p) { a.ph_lo = p; a.ph_hi = p + 1;
        hipLaunchKernelGGL(layer_fwd, dim3(grid), dim3(NWAVES * 64), LDS_BYTES, stream, a); }
#endif
}
```

```cpp
#include <hip/hip_runtime.h>
#include <hip/hip_cooperative_groups.h>
#include <cstdio>
#include <cstdint>
namespace cg = cooperative_groups;
#ifndef ONE_LAUNCH
#define ONE_LAUNCH 1
#endif
namespace pg8 {
#define PG8_LAS __attribute__((address_space(3)))
typedef unsigned short bf16_t;
typedef short bf16x8 __attribute__((ext_vector_type(8)));
typedef float f32x4 __attribute__((ext_vector_type(4)));
typedef unsigned u32x4 __attribute__((ext_vector_type(4)));
constexpr int BM = 256, BK = 64, HALF = 128, HTB = HALF * BK * 2  , STAGE_BYTES = 8 * HTB, NXCD = 8, WGM = 8;

__host__ __device__ __forceinline__ int lds_byte(int r, int c) { const int st = (r >> 4) * 2 + (c >> 5), rr = r & 15, cc = c & 31, ob = rr * 64 + cc * 2; return st * 1024 + (ob ^ (((ob >> 9) & 1) << 5)); }
__host__ __device__ __forceinline__ void stage_rc(int b, int& R, int& C) { const int st = b / 1024, sb = b % 1024, swz = sb ^ (((sb >> 9) & 1) << 5); R = (st >> 1) * 16 + swz / 64; C = (st & 1) * 32 + (swz % 64) / 2; }
__host__ __device__ __forceinline__ int perm32(int rho) { const int n = rho >> 4, i = rho & 15; return 8 * (i >> 2) + 4 * n + (i & 3); }

struct Unit { int pm, pn; };
struct Gemm { const bf16_t* A; const bf16_t* Bt; int M, N, K; };

struct StaticOrder {
    int nM, nN, nwg, G, c, wgm;
    __host__ __device__ void init(int M, int N, int G_, int c_, int wgm_ = WGM) { nM = M / BM; nN = N / BM; nwg = nM * nN; G = G_; c = c_; wgm = wgm_; }
    __host__ __device__ bool next(int i, Unit& u) const {
        const long L = (long)i * G + c; if (L >= nwg) return false;
        int wgid = (int)L; { const int q = nwg / NXCD, r = nwg % NXCD, xcd = wgid % NXCD, off = wgid / NXCD; wgid = (xcd < r ? xcd * (q + 1) : r * (q + 1) + (xcd - r) * q) + off; }
        const int nig = wgm * nN, gid = wgid / nig, fm = gid * wgm, gsz = (nM - fm) < wgm ? (nM - fm) : wgm;
        u.pm = fm + ((wgid % nig) % gsz); u.pn = (wgid % nig) / gsz; return true;
    }
    __device__ __forceinline__ void a_ready(const Unit&) const {}
    __device__ __forceinline__ void done(const Unit&) const {}
};
__device__ __forceinline__ unsigned cvt_pk_bf16(float lo, float hi) { unsigned r; asm volatile("v_cvt_pk_bf16_f32 %0, %1, %2" : "=v"(r) : "v"(lo), "v"(hi)); return r; }
constexpr float RMS_EPS = 1e-6f;
__device__ __forceinline__ float fast_sigmoid(float g) { return __builtin_amdgcn_rcpf(1.0f + __builtin_amdgcn_exp2f(-1.4426950408889634f * g)); }
__device__ __forceinline__ f32x4 bf2f_lo(unsigned a, unsigned b) { f32x4 r; r[0] = __uint_as_float(a << 16); r[1] = __uint_as_float(a & 0xffff0000u); r[2] = __uint_as_float(b << 16); r[3] = __uint_as_float(b & 0xffff0000u); return r; }

__device__ __forceinline__ float sum_xor32(float v) { auto r = __builtin_amdgcn_permlane32_swap(__float_as_uint(v), __float_as_uint(v), false, false); return __uint_as_float(r[0]) + __uint_as_float(r[1]); }
__device__ __forceinline__ float sum_xor16(float v) { auto r = __builtin_amdgcn_permlane16_swap(__float_as_uint(v), __float_as_uint(v), false, false); return __uint_as_float(r[0]) + __uint_as_float(r[1]); }
__device__ __forceinline__ float get_xor32(float v, bool upper) { auto r = __builtin_amdgcn_permlane32_swap(__float_as_uint(v), __float_as_uint(v), false, false); return __uint_as_float(upper ? r[0] : r[1]); }
template <bool KB64> struct EpiSwiglu {
    static constexpr bool PERM = true, AFTER_DRAIN = false, HAS_MID = false, KP = false;
    bf16_t* H; int ldh; const float* ss; int mrows;
    __device__ __forceinline__ void operator()(const f32x4 (&acc)[2][2][4][2], const Unit& u, int wr, int wc, int fr, int fq) const {
        const int row0 = u.pm * BM + wr * 64 + fr, col0 = u.pn * HALF + wc * 32 + 8 * fq;
#pragma unroll
        for (int ai = 0; ai < 2; ++ai)
#pragma unroll
            for (int m = 0; m < 4; ++m) { const int row = row0 + ai * HALF + m * 16; const float rs = rsqrtf(ss[row] * (1.0f / 2048.0f) + RMS_EPS);
                float h[8];
#pragma unroll
                for (int n = 0; n < 2; ++n)
#pragma unroll
                    for (int j = 0; j < 4; ++j) { const float g = acc[ai][0][m][n][j] * rs, up = acc[ai][1][m][n][j] * rs; h[n * 4 + j] = g * fast_sigmoid(g) * up; }
                u32x4 w; w.x = cvt_pk_bf16(h[0], h[1]); w.y = cvt_pk_bf16(h[2], h[3]); w.z = cvt_pk_bf16(h[4], h[5]); w.w = cvt_pk_bf16(h[6], h[7]);
                if (KB64) *(u32x4*)(H + (size_t)(col0 >> 6) * ((size_t)mrows * 64) + (size_t)row * 64 + (col0 & 63)) = w;
                else *(u32x4*)(H + (size_t)row * ldh + col0) = w; }
    }
};
template <bool BASE_F32, bool OUT_F32, bool NT_BASE = false> struct EpiResid {
    static constexpr bool PERM = true, AFTER_DRAIN = false, HAS_MID = false, KP = OUT_F32;
    const void* base; float* out; bf16_t* xb; float* ss; float alpha; int ld;
    __device__ __forceinline__ void operator()(const f32x4 (&acc)[2][2][4][2], const Unit& u, int wr, int wc, int fr, int fq) const {
        const int row0 = u.pm * BM + wr * 64 + fr, col0 = u.pn * BM + wc * 32 + 8 * fq;
#pragma unroll
        for (int ai = 0; ai < 2; ++ai) {
            f32x4 bf[4][2][2]; u32x4 bh[4][2];
#pragma unroll
            for (int m = 0; m < 4; ++m)
#pragma unroll
                for (int bj = 0; bj < 2; ++bj) { const size_t p = (size_t)(row0 + ai * HALF + m * 16) * ld + col0 + bj * HALF;
                    if (BASE_F32) { if (NT_BASE) { bf[m][bj][0] = __builtin_nontemporal_load((const f32x4*)((const float*)base + p)); bf[m][bj][1] = __builtin_nontemporal_load((const f32x4*)((const float*)base + p + 4)); }
                                    else { bf[m][bj][0] = *(const f32x4*)((const float*)base + p); bf[m][bj][1] = *(const f32x4*)((const float*)base + p + 4); } }
                    else { if (NT_BASE) bh[m][bj] = __builtin_nontemporal_load((const u32x4*)((const bf16_t*)base + p)); else bh[m][bj] = *(const u32x4*)((const bf16_t*)base + p); } }
            asm volatile("" ::: "memory");
#pragma unroll
            for (int m = 0; m < 4; ++m) { const int row = row0 + ai * HALF + m * 16; float s = 0.f;
#pragma unroll
                for (int bj = 0; bj < 2; ++bj) { const size_t p = (size_t)row * ld + col0 + bj * HALF;
                    f32x4 b0, b1;
                    if (BASE_F32) { b0 = bf[m][bj][0]; b1 = bf[m][bj][1]; }
                    else { b0 = bf2f_lo(bh[m][bj].x, bh[m][bj].y); b1 = bf2f_lo(bh[m][bj].z, bh[m][bj].w); }
                    const f32x4 v0 = b0 + acc[ai][bj][m][0] * alpha, v1 = b1 + acc[ai][bj][m][1] * alpha;
                    if (OUT_F32) { __builtin_nontemporal_store(v0, (f32x4*)(out + p)); __builtin_nontemporal_store(v1, (f32x4*)(out + p + 4)); }
                    if (xb) { u32x4 w; w.x = cvt_pk_bf16(v0[0], v0[1]); w.y = cvt_pk_bf16(v0[2], v0[3]); w.z = cvt_pk_bf16(v1[0], v1[1]); w.w = cvt_pk_bf16(v1[2], v1[3]); *(u32x4*)(xb + p) = w; }
                    s += (v0[0] * v0[0] + v0[1] * v0[1]) + (v0[2] * v0[2] + v0[3] * v0[3]) + (v1[0] * v1[0] + v1[1] * v1[1]) + (v1[2] * v1[2] + v1[3] * v1[3]); }
                if (ss) { s = sum_xor16(s); s = sum_xor32(s); if (fq == 0) atomicAdd(ss + row, s); } }
            asm volatile("" ::: "memory");
        }
    }
};
struct EpiProj {
    static constexpr bool PERM = true, AFTER_DRAIN = false, HAS_MID = false, KP = false;
    bf16_t* O0; int ld0; bf16_t* O1; int ld1; int split_pn; const float* ss;
    const float* gdq; const float* gdk; const float* gfq; const float* gfk; const float* cosT; const float* sinT; PG8_LAS float* P;
    __device__ __forceinline__ void operator()(const f32x4 (&acc_)[2][2][4][2], const Unit& u, int wr, int wc, int fr, int fq) const {
        f32x4 (&acc)[2][2][4][2] = const_cast<f32x4 (&)[2][2][4][2]>(acc_);
        const int pn = u.pn;
        const int kind = pn < 6 ? 0 : (pn < 12 ? 1 : ((pn >= 18 && pn < 22) ? 2 : ((pn >= 22 && pn < 26) ? 3 : -1)));
        const int rl0 = wr * 64 + fr, row0 = pn * 0 + u.pm * BM + rl0; const bool first = pn < split_pn;
        bf16_t* O = first ? O0 : O1; const int ld = first ? ld0 : ld1; const int col0 = (first ? pn : pn - split_pn) * BM + wc * 32 + 8 * fq;
#pragma unroll
        for (int ai = 0; ai < 2; ++ai)
#pragma unroll
            for (int m = 0; m < 4; ++m) { const int rl = rl0 + ai * HALF + m * 16; const float rs = rsqrtf(ss[u.pm * BM + rl] * (1.0f / 2048.0f) + RMS_EPS);
#pragma unroll
                for (int bj = 0; bj < 2; ++bj) { acc[ai][bj][m][0] = acc[ai][bj][m][0] * rs; acc[ai][bj][m][1] = acc[ai][bj][m][1] * rs;
                    if (kind >= 0) { const f32x4 a = acc[ai][bj][m][0], b = acc[ai][bj][m][1];
                        float s = (a[0] * a[0] + a[1] * a[1]) + (a[2] * a[2] + a[3] * a[3]) + (b[0] * b[0] + b[1] * b[1]) + (b[2] * b[2] + b[3] * b[3]);
                        s = sum_xor16(s); s = sum_xor32(s);
                        if (fq == 0) P[(rl * 2 + bj) * 4 + wc] = s; } } }
        f32x4 g0 = {1.f, 1.f, 1.f, 1.f}, g1 = g0;
        if (kind >= 0) {
            asm volatile("s_waitcnt lgkmcnt(0)" ::: "memory"); __builtin_amdgcn_s_barrier(); asm volatile("" ::: "memory");
            const float* gp = (kind == 0 ? gdq : (kind == 1 ? gdk : (kind == 2 ? gfq : gfk))) + wc * 32 + 8 * fq;
            g0 = *(const f32x4*)gp; g1 = *(const f32x4*)(gp + 4);
        }
        const bool rope = kind >= 0 && wc == 0; const float sgn = fq < 2 ? -1.0f : 1.0f;
#pragma unroll
        for (int ai = 0; ai < 2; ++ai)
#pragma unroll
            for (int m = 0; m < 4; ++m) { const int rl = rl0 + ai * HALF + m * 16, row = u.pm * BM + rl;
                f32x4 c0, c1, s0, s1;
                if (rope) { const float* cp = cosT + (size_t)row * 16 + 8 * (fq & 1); const float* sp = sinT + (size_t)row * 16 + 8 * (fq & 1);
                    c0 = *(const f32x4*)cp; c1 = *(const f32x4*)(cp + 4); s0 = *(const f32x4*)sp; s1 = *(const f32x4*)(sp + 4); }
#pragma unroll
                for (int bj = 0; bj < 2; ++bj) { f32x4 v0 = acc[ai][bj][m][0], v1 = acc[ai][bj][m][1];
                    if (kind >= 0) { const f32x4 p4 = *(const PG8_LAS f32x4*)(P + (rl * 2 + bj) * 4);
                        const float rh = rsqrtf(((p4[0] + p4[1]) + (p4[2] + p4[3])) * (1.0f / 128.0f) + RMS_EPS);
                        v0 = v0 * rh * g0; v1 = v1 * rh * g1;
                        if (rope) {
#pragma unroll
                            for (int j = 0; j < 4; ++j) { const float p0 = get_xor32(v0[j], fq >= 2), p1 = get_xor32(v1[j], fq >= 2);
                                v0[j] = v0[j] * c0[j] + sgn * p0 * s0[j]; v1[j] = v1[j] * c1[j] + sgn * p1 * s1[j]; } } }
                    u32x4 w; w.x = cvt_pk_bf16(v0[0], v0[1]); w.y = cvt_pk_bf16(v0[2], v0[3]); w.z = cvt_pk_bf16(v1[0], v1[1]); w.w = cvt_pk_bf16(v1[2], v1[3]);
                    *(u32x4*)(O + (size_t)row * ld + col0 + bj * HALF) = w; } }
    }
};
struct EpiGateMerge {
    static constexpr bool PERM = true, AFTER_DRAIN = false, HAS_MID = true, KP = false;
    const bf16_t* gate; int ldg; bf16_t* Y; int ldy; int mid_t;
    __device__ __forceinline__ void mid(f32x4 (&acc)[2][2][4][2], const Unit& u, int wr, int wc, int fr, int fq) const {
        int row0 = u.pm * BM + wr * 64 + fr, col0 = u.pn * BM + wc * 32 + 8 * fq;
        asm volatile("" : "+v"(row0), "+v"(col0));
#pragma unroll
        for (int ai = 0; ai < 2; ++ai)
#pragma unroll
            for (int m = 0; m < 4; ++m)
#pragma unroll
                for (int bj = 0; bj < 2; ++bj) { const bf16_t* gp = gate + (size_t)(row0 + ai * HALF + m * 16) * ldg + col0 + bj * HALF;
                    const u32x4 ga = *(const u32x4*)gp, gb = *(const u32x4*)(gp + 2048);
                    const f32x4 a0 = bf2f_lo(ga.x, ga.y), a1 = bf2f_lo(ga.z, ga.w), b0 = bf2f_lo(gb.x, gb.y), b1 = bf2f_lo(gb.z, gb.w);
#pragma unroll
                    for (int j = 0; j < 4; ++j) {
                        acc[ai][bj][m][0][j] *= (1.0f + __builtin_amdgcn_exp2f(-1.4426950408889634f * b0[j])) * __builtin_amdgcn_rcpf(1.0f + __builtin_amdgcn_exp2f(-1.4426950408889634f * a0[j]));
                        acc[ai][bj][m][1][j] *= (1.0f + __builtin_amdgcn_exp2f(-1.4426950408889634f * b1[j])) * __builtin_amdgcn_rcpf(1.0f + __builtin_amdgcn_exp2f(-1.4426950408889634f * a1[j])); }
                    asm volatile("" ::: "memory"); }
    }
    __device__ __forceinline__ void operator()(const f32x4 (&acc)[2][2][4][2], const Unit& u, int wr, int wc, int fr, int fq) const {
        const int row0 = u.pm * BM + wr * 64 + fr, col0 = u.pn * BM + wc * 32 + 8 * fq;
#pragma unroll
        for (int ai = 0; ai < 2; ++ai)
#pragma unroll
            for (int m = 0; m < 4; ++m) { const int row = row0 + ai * HALF + m * 16;
#pragma unroll
                for (int bj = 0; bj < 2; ++bj) { const int col = col0 + bj * HALF;
                    const u32x4 gw = *(const u32x4*)(gate + (size_t)row * ldg + 2048 + col);
                    const f32x4 g0 = bf2f_lo(gw.x, gw.y), g1 = bf2f_lo(gw.z, gw.w);
                    f32x4 v0, v1;
#pragma unroll
                    for (int j = 0; j < 4; ++j) { v0[j] = fast_sigmoid(g0[j]) * acc[ai][bj][m][0][j]; v1[j] = fast_sigmoid(g1[j]) * acc[ai][bj][m][1][j]; }
                    u32x4 w; w.x = cvt_pk_bf16(v0[0], v0[1]); w.y = cvt_pk_bf16(v0[2], v0[3]); w.z = cvt_pk_bf16(v1[0], v1[1]); w.w = cvt_pk_bf16(v1[2], v1[3]);
                    *(u32x4*)(Y + (size_t)row * ldy + col) = w; } }
    }
};

template <class Epi, class Sched, bool ALIGN_EPI = false, bool SP2 = false, bool KB64 = false>
__device__ __forceinline__ void gemm_phase(PG8_LAS unsigned char* lds, const Gemm g, const Sched& S, const Epi& E) {
    int tid_ = threadIdx.x; asm volatile("" : "+v"(tid_));
    const int tid = tid_, wid = __builtin_amdgcn_readfirstlane(tid >> 6), lane = tid & 63, wr = wid >> 2, wc = wid & 3, fr = lane & 15, fq = lane >> 4;
    const int K = g.K, nt = K / BK;
    unsigned voffA[2], voffB[2];
#pragma unroll
    for (int i = 0; i < 2; ++i) { int R, C; stage_rc(tid * 16 + i * 8192, R, C); const int Rb = Epi::PERM ? ((R & ~31) + perm32(R & 31)) : R;
        voffA[i] = (unsigned)(R * (KB64 ? 64 : K) + C) * 2u; voffB[i] = (unsigned)(Rb * (KB64 ? 64 : K) + C) * 2u; }
    const size_t kstepA = KB64 ? (size_t)g.M * (BK * 2) : (size_t)(BK * 2), kstepB = KB64 ? (size_t)g.N * (BK * 2) : (size_t)(BK * 2);
    const size_t hstep = KB64 ? (size_t)HALF * BK * 2 : (size_t)HALF * K * 2;
    const size_t tstep = 2 * hstep;
    const unsigned ldsw = (unsigned)wid * 1024u;
    const int aoff = lds_byte(wr * 64 + fr, fq * 8), boff = lds_byte(wc * 32 + fr, fq * 8);
#define PG8_SA(b, h) (((b) * 2 + (h)) * HTB)
#define PG8_SB(b, h) ((4 + (b) * 2 + (h)) * HTB)
#define PG8_STAGE(bufoff, gbase, voff) do { _Pragma("unroll") for (int _i = 0; _i < 2; ++_i) \
        __builtin_amdgcn_global_load_lds((const unsigned*)((const char*)(gbase) + (voff)[_i]), (PG8_LAS unsigned*)(lds + (bufoff) + ldsw + _i * 8192), 16, 0, 0); } while (0)
#define PG8_LDA(dst, b, h) do { _Pragma("unroll") for (int m = 0; m < 4; ++m) _Pragma("unroll") for (int k = 0; k < 2; ++k) dst[m][k] = *(const PG8_LAS bf16x8*)(lds + PG8_SA(b, h) + aoff + m * 2048 + k * 1024); } while (0)
#define PG8_LDB(dst, b, h) do { _Pragma("unroll") for (int n = 0; n < 2; ++n) _Pragma("unroll") for (int k = 0; k < 2; ++k) dst[n][k] = *(const PG8_LAS bf16x8*)(lds + PG8_SB(b, h) + boff + n * 2048 + k * 1024); } while (0)
#define PG8_MMA(ai, bj, At, Bt) do { __builtin_amdgcn_s_setprio(1); _Pragma("unroll") for (int m = 0; m < 4; ++m) _Pragma("unroll") for (int n = 0; n < 2; ++n) _Pragma("unroll") for (int k = 0; k < 2; ++k) \
        acc[ai][bj][m][n] = __builtin_amdgcn_mfma_f32_16x16x32_bf16(Bt[n][k], At[m][k], acc[ai][bj][m][n], 0, 0, 0); __builtin_amdgcn_s_setprio(0); } while (0)
#define PG8_WAIT_V(n) asm volatile("s_waitcnt vmcnt(" #n ")" ::: "memory")
#define PG8_WAIT_L(n) asm volatile("s_waitcnt lgkmcnt(" #n ")" ::: "memory")
#define PG8_BAR __builtin_amdgcn_s_barrier()
#define PG8_SCHED __builtin_amdgcn_sched_barrier(0)
    Unit cur, nxt; int ui = 0;
    if (!S.next(0, cur)) return;
    f32x4 acc[2][2][4][2];
#pragma unroll
    for (int a = 0; a < 2; ++a)
#pragma unroll
        for (int b = 0; b < 2; ++b)
#pragma unroll
            for (int m = 0; m < 4; ++m)
#pragma unroll
                for (int n = 0; n < 2; ++n) acc[a][b][m][n] = (f32x4){0.f, 0.f, 0.f, 0.f};
    bf16x8 At[4][2], B0[2][2], B1[2][2];
    const char* cA = (const char*)g.A + (size_t)cur.pm * tstep; const char* cB = (const char*)g.Bt + (size_t)cur.pn * tstep;
    S.a_ready(cur);
    if constexpr (SP2) {
        PG8_STAGE(PG8_SB(0, 0), cB, voffB); PG8_STAGE(PG8_SB(0, 1), cB + hstep, voffB); PG8_STAGE(PG8_SA(0, 0), cA, voffA); PG8_STAGE(PG8_SA(0, 1), cA + hstep, voffA);
        if (wr == 1) PG8_BAR;
        PG8_WAIT_V(2); PG8_BAR;
        PG8_STAGE(PG8_SB(1, 0), cB + kstepB, voffB); PG8_STAGE(PG8_SA(1, 0), cA + kstepA, voffA); PG8_STAGE(PG8_SB(1, 1), cB + hstep + kstepB, voffB);
        PG8_WAIT_V(6); PG8_BAR;
    } else {
        PG8_STAGE(PG8_SB(0, 0), cB, voffB); PG8_STAGE(PG8_SA(0, 0), cA, voffA); PG8_STAGE(PG8_SB(0, 1), cB + hstep, voffB); PG8_STAGE(PG8_SA(0, 1), cA + hstep, voffA);
        if (wr == 1) PG8_BAR;
        PG8_WAIT_V(4); PG8_BAR;
        PG8_STAGE(PG8_SB(1, 0), cB + kstepB, voffB); PG8_STAGE(PG8_SA(1, 0), cA + kstepA, voffA); PG8_STAGE(PG8_SB(1, 1), cB + hstep + kstepB, voffB);
        PG8_WAIT_V(6); PG8_BAR;
    }
    for (;;) {
        const bool has_next = S.next(ui + 1, nxt);
        const char* nA = has_next ? (const char*)g.A + (size_t)nxt.pm * tstep : cA; const char* nB = has_next ? (const char*)g.Bt + (size_t)nxt.pn * tstep : cB;
#ifdef PROBE_KLOOP
#ifdef PROBE_KCYC
        const unsigned long long pk_t0 = __builtin_amdgcn_s_memtime();
#else
        const unsigned long long pk_t0 = __builtin_amdgcn_s_memrealtime();
#endif
#endif
        for (int t = 0; t < nt; t += 2) {
            const bool last = (t == nt - 2);
            const char* a1 = cA + (size_t)(t + 1) * kstepA;
            const char* a2 = last ? nA : cA + (size_t)(t + 2) * kstepA; const char* b2 = last ? nB : cB + (size_t)(t + 2) * kstepB;
            const char* a3 = a2 + kstepA; const char* b3 = b2 + kstepB;
#ifdef KPAUSE
            if constexpr (Epi::KP) { if (t == 32 || t == 64) { __builtin_amdgcn_s_sleep(KPAUSE); } }
#endif
            if constexpr (Epi::HAS_MID) { if (t == E.mid_t) E.mid(acc, cur, wr, wc, fr, fq); }
            if (last && has_next) S.a_ready(nxt);
            if constexpr (SP2) {
            PG8_LDB(B0, 0, 0); PG8_LDB(B1, 0, 1); PG8_SCHED; PG8_LDA(At, 0, 0); PG8_STAGE(PG8_SA(1, 1), a1 + hstep, voffA);
            PG8_WAIT_V(8); PG8_WAIT_L(0); PG8_BAR; PG8_MMA(0, 0, At, B0); PG8_MMA(0, 1, At, B1); PG8_BAR; PG8_SCHED;
            PG8_LDA(At, 0, 1); PG8_STAGE(PG8_SB(0, 0), b2, voffB); PG8_STAGE(PG8_SB(0, 1), b2 + hstep, voffB); PG8_STAGE(PG8_SA(0, 0), a2, voffA);
            PG8_WAIT_V(8); PG8_WAIT_L(0); PG8_BAR; PG8_MMA(1, 0, At, B0); PG8_MMA(1, 1, At, B1); PG8_BAR; PG8_SCHED;
            PG8_LDB(B0, 1, 0); PG8_LDB(B1, 1, 1); PG8_SCHED; PG8_LDA(At, 1, 0); PG8_STAGE(PG8_SA(0, 1), a2 + hstep, voffA);
            PG8_WAIT_V(8); PG8_WAIT_L(0); PG8_BAR; PG8_MMA(0, 0, At, B0); PG8_MMA(0, 1, At, B1); PG8_BAR; PG8_SCHED;
            PG8_LDA(At, 1, 1); PG8_STAGE(PG8_SB(1, 0), b3, voffB); PG8_STAGE(PG8_SB(1, 1), b3 + hstep, voffB); PG8_STAGE(PG8_SA(1, 0), a3, voffA);
            PG8_WAIT_V(8); PG8_WAIT_L(0); PG8_BAR; PG8_MMA(1, 0, At, B0); PG8_MMA(1, 1, At, B1); PG8_BAR; PG8_SCHED;
            } else {
            PG8_LDB(B0, 0, 0); PG8_SCHED; PG8_LDA(At, 0, 0); PG8_STAGE(PG8_SA(1, 1), a1 + hstep, voffA);
            PG8_WAIT_L(8); PG8_BAR; PG8_WAIT_L(0); PG8_MMA(0, 0, At, B0); PG8_BAR; PG8_SCHED;
            PG8_LDB(B1, 0, 1); PG8_STAGE(PG8_SB(0, 0), b2, voffB);
            PG8_BAR; PG8_WAIT_L(0); PG8_MMA(0, 1, At, B1); PG8_BAR;
            PG8_LDA(At, 0, 1); PG8_STAGE(PG8_SA(0, 0), a2, voffA);
            PG8_BAR; PG8_WAIT_L(0); PG8_MMA(1, 0, At, B0); PG8_BAR; PG8_SCHED;
            PG8_STAGE(PG8_SB(0, 1), b2 + hstep, voffB);
            PG8_WAIT_V(6); PG8_BAR; PG8_MMA(1, 1, At, B1); PG8_BAR;
            PG8_LDB(B0, 1, 0); PG8_SCHED; PG8_LDA(At, 1, 0); PG8_STAGE(PG8_SA(0, 1), a2 + hstep, voffA);
            PG8_WAIT_L(8); PG8_BAR; PG8_WAIT_L(0); PG8_MMA(0, 0, At, B0); PG8_BAR; PG8_SCHED;
            PG8_LDB(B1, 1, 1); PG8_STAGE(PG8_SB(1, 0), b3, voffB);
            PG8_BAR; PG8_WAIT_L(0); PG8_MMA(0, 1, At, B1); PG8_BAR;
            PG8_LDA(At, 1, 1); PG8_STAGE(PG8_SA(1, 0), a3, voffA);
            PG8_BAR; PG8_WAIT_L(0); PG8_MMA(1, 0, At, B0); PG8_BAR; PG8_SCHED;
            PG8_STAGE(PG8_SB(1, 1), b3 + hstep, voffB);
            PG8_WAIT_V(6); PG8_BAR; PG8_MMA(1, 1, At, B1); PG8_BAR;
            }
        }
#ifdef PROBE_KLOOP
#ifdef PROBE_KCYC
        if (tid == 0) *(PG8_LAS unsigned*)(lds + 139264 + 64) += (unsigned)((__builtin_amdgcn_s_memtime() - pk_t0) / 20);
#else
        if (tid == 0) *(PG8_LAS unsigned*)(lds + 139264 + 64) += (unsigned)(__builtin_amdgcn_s_memrealtime() - pk_t0);
#endif
#endif
        if constexpr (ALIGN_EPI) { if (wr == 0) PG8_BAR; }
        if constexpr (!Epi::AFTER_DRAIN) { E(acc, cur, wr, wc, fr, fq); S.done(cur); }
        if (!has_next) break;
#pragma unroll
        for (int a = 0; a < 2; ++a)
#pragma unroll
            for (int b = 0; b < 2; ++b)
#pragma unroll
                for (int m = 0; m < 4; ++m)
#pragma unroll
                    for (int n = 0; n < 2; ++n) acc[a][b][m][n] = (f32x4){0.f, 0.f, 0.f, 0.f};
        cur = nxt; cA = nA; cB = nB; ++ui;
        if constexpr (ALIGN_EPI) { if (wr == 1) PG8_BAR; }
    }
    PG8_WAIT_V(0);
    if constexpr (!ALIGN_EPI) { if (wr == 0) PG8_BAR; }
    PG8_BAR;
    if constexpr (Epi::AFTER_DRAIN) { E.fused(acc, cur, wr, wc, fr, fq, lds, wid, lane); S.done(cur); }
#undef PG8_SA
#undef PG8_SB
#undef PG8_STAGE
#undef PG8_LDA
#undef PG8_LDB
#undef PG8_MMA
#undef PG8_WAIT_V
#undef PG8_WAIT_L
#undef PG8_BAR
#undef PG8_SCHED
}
}
namespace att {
typedef unsigned short bf16_t;
typedef short bf16x8 __attribute__((ext_vector_type(8)));
typedef short s16x4 __attribute__((ext_vector_type(4)));
typedef float f32x16 __attribute__((ext_vector_type(16)));
typedef float f32x4 __attribute__((ext_vector_type(4)));
typedef unsigned u32x4 __attribute__((ext_vector_type(4)));
constexpr int D = 128;
constexpr float SCALE = 0.08838834764831845f;
constexpr float THR = 8.f;
constexpr int NW = 8, QBLK = 32, KVBLK = 64, QB = NW * QBLK;
constexpr int SHM_V = KVBLK * D * 2, SHM_K = KVBLK * D * 2;
constexpr int LDS_BYTES = 2 * SHM_V + 2 * SHM_K + NW * 64 * 4;

#define KSWZ(row, colB) ((row) * 256 + ((colB) ^ (((row) & 7) << 4)))
#define SBAR() __builtin_amdgcn_sched_barrier(0)
__device__ __forceinline__ int v_st(int k, int c) { const int kk = (k & ~0xC) | ((k & 4) << 1) | ((k & 8) >> 1); return ((kk >> 3) * 4 + (c >> 5)) * 512 + ((kk & 7) * 32 + (c & 31)) * 2; }
__device__ __forceinline__ int v_rd_base(int lane) { return ((lane & 3) << 3) | (((lane >> 2) & 3) << 6) | (((lane >> 4) & 1) << 5) | (((lane >> 5) & 1) << 8); }
constexpr int v_rd_off(int d0, int ks, int half) { return d0 * 512 + ks * 4096 + half * 2048; }
__device__ __forceinline__ int crow(int r, int hi) { return (r & 3) + 8 * (r >> 2) + 4 * hi; }
__device__ __forceinline__ unsigned cvtpk(float lo, float hi) { unsigned r; asm volatile("v_cvt_pk_bf16_f32 %0, %1, %2" : "=v"(r) : "v"(lo), "v"(hi)); return r; }
__device__ __forceinline__ bf16x8 ld8(const bf16_t* p) { return *reinterpret_cast<const bf16x8*>(p); }
__device__ __forceinline__ void mask_tile(f32x16& p0, f32x16& p1, int dq, unsigned W) {
    const float NEG = -__builtin_inff();
#pragma unroll
    for (int r = 0; r < 16; ++r) {
        const int c = (r & 3) + 8 * (r >> 2);
        if ((unsigned)(dq - c) >= W) p0[r] = NEG;
        if ((unsigned)(dq - c - 32) >= W) p1[r] = NEG;
    }
}
__device__ __forceinline__ void partialSM(f32x16& p0, f32x16& p1, float& m_reg, float& mn, float& alpha) {
    float pmax = p0[0]; for (int r = 1; r < 16; ++r) pmax = fmaxf(pmax, p0[r]); for (int r = 0; r < 16; ++r) pmax = fmaxf(pmax, p1[r]);
    { auto rr = __builtin_amdgcn_permlane32_swap(__float_as_uint(pmax), __float_as_uint(pmax), false, false);
      pmax = fmaxf(__uint_as_float(rr[0]), __uint_as_float(rr[1])); }
    constexpr float C2 = 1.4426950408889634f * SCALE;
    if (__builtin_expect(__all((pmax - m_reg) * SCALE <= THR), 1)) { mn = m_reg; alpha = 1.f; }
    else { mn = fmaxf(m_reg, pmax); alpha = __builtin_amdgcn_exp2f((m_reg - mn) * C2); m_reg = mn; }
    const float mnL = -mn * C2;
    for (int r = 0; r < 16; ++r) p0[r] = fmaf(p0[r], C2, mnL); for (int r = 0; r < 16; ++r) p1[r] = fmaf(p1[r], C2, mnL);
    for (int r = 0; r < 16; ++r) p0[r] = __builtin_amdgcn_exp2f(p0[r]);
}
__device__ __forceinline__ void finishSM(f32x16& p0, f32x16& p1, float alpha, float& l_reg, bf16x8& pa0, bf16x8& pa1, bf16x8& pa2, bf16x8& pa3) {
    for (int r = 0; r < 16; ++r) p1[r] = __builtin_amdgcn_exp2f(p1[r]);
    float ps = 0; for (int r = 0; r < 16; ++r) ps += p0[r]; for (int r = 0; r < 16; ++r) ps += p1[r];
    { auto rr = __builtin_amdgcn_permlane32_swap(__float_as_uint(ps), __float_as_uint(ps), false, false);
      ps = __uint_as_float(rr[0]) + __uint_as_float(rr[1]); }
    l_reg = l_reg * alpha + ps;
#define PK4(P, B_, OUT) do { unsigned a0 = cvtpk(P[B_+0], P[B_+1]), a1 = cvtpk(P[B_+2], P[B_+3]);                          \
        unsigned b0 = cvtpk(P[B_+4], P[B_+5]), b1 = cvtpk(P[B_+6], P[B_+7]);                                             \
        auto r0 = __builtin_amdgcn_permlane32_swap(a0, b0, false, false); auto r1 = __builtin_amdgcn_permlane32_swap(a1, b1, false, false); \
        u32x4 w = {r0[0], r1[0], r0[1], r1[1]}; OUT = *reinterpret_cast<bf16x8*>(&w); } while (0)
    PK4(p0, 0, pa0); PK4(p0, 8, pa1); PK4(p1, 0, pa2); PK4(p1, 8, pa3);
#undef PK4
}
template <int KB>
__device__ __forceinline__ void qkt(f32x16& p0, f32x16& p1, const char* K_lds, int r32, int hi, const bf16x8* qr) {
    p0 = f32x16{}; p1 = f32x16{};
    const char* kb[4];
#pragma unroll
    for (int dd = 0; dd < 4; ++dd) kb[dd] = K_lds + KB * SHM_K + KSWZ(r32, (dd * 16 + hi * 8) * 2);
#pragma unroll
    for (int d0 = 0; d0 < 8; ++d0) { const char* a = kb[d0 & 3] + (d0 >> 2) * 128;
        bf16x8 b0 = *reinterpret_cast<const bf16x8*>(a);
        bf16x8 b1 = *reinterpret_cast<const bf16x8*>(a + 32 * 256);
        p0 = __builtin_amdgcn_mfma_f32_32x32x16_bf16(b0, qr[d0], p0, 0, 0, 0);
        p1 = __builtin_amdgcn_mfma_f32_32x32x16_bf16(b1, qr[d0], p1, 0, 0, 0); }
}
template <int VB, int VSTRIDE = SHM_V>
__device__ __forceinline__ void pv_tile(f32x16* o, int vb0, bf16x8 pa0, bf16x8 pa1, bf16x8 pa2, bf16x8 pa3) {
#define TRRD(dst, off) asm volatile("ds_read_b64_tr_b16 %0, %1 offset:%2" : "=&v"(dst) : "v"(vb0), "i"(off) : "memory")
#define PV_D0(d0) do { s16x4 l0, l1, l2, l3, h0, h1, h2, h3; constexpr int b_ = VB * VSTRIDE + v_rd_off(d0, 0, 0);   \
        TRRD(l0, b_); TRRD(h0, b_ + 2048); TRRD(l1, b_ + 4096); TRRD(h1, b_ + 6144); TRRD(l2, b_ + 8192); TRRD(h2, b_ + 10240); TRRD(l3, b_ + 12288); TRRD(h3, b_ + 14336); \
        asm volatile("s_waitcnt lgkmcnt(0)" ::: "memory"); SBAR();   \
        o[d0] = __builtin_amdgcn_mfma_f32_32x32x16_bf16(pa0, (bf16x8){l0[0], l0[1], l0[2], l0[3], h0[0], h0[1], h0[2], h0[3]}, o[d0], 0, 0, 0);   \
        o[d0] = __builtin_amdgcn_mfma_f32_32x32x16_bf16(pa1, (bf16x8){l1[0], l1[1], l1[2], l1[3], h1[0], h1[1], h1[2], h1[3]}, o[d0], 0, 0, 0);   \
        o[d0] = __builtin_amdgcn_mfma_f32_32x32x16_bf16(pa2, (bf16x8){l2[0], l2[1], l2[2], l2[3], h2[0], h2[1], h2[2], h2[3]}, o[d0], 0, 0, 0);   \
        o[d0] = __builtin_amdgcn_mfma_f32_32x32x16_bf16(pa3, (bf16x8){l3[0], l3[1], l3[2], l3[3], h3[0], h3[1], h3[2], h3[3]}, o[d0], 0, 0, 0); } while (0)
    PV_D0(0); PV_D0(1); PV_D0(2); PV_D0(3);
#undef PV_D0
#undef TRRD
}


template <int B>
__device__ __forceinline__ void pv_wide(f32x16* o, int vb0, bf16x8 pa0, bf16x8 pa1, bf16x8 pa2, bf16x8 pa3) {
#define TRRD(dst, off) asm volatile("ds_read_b64_tr_b16 %0, %1 offset:%2" : "=&v"(dst) : "v"(vb0), "i"(off) : "memory")
#define RD8(S, g) do { constexpr int b_ = B * 32768 + ((g) >> 2) * 16384 + v_rd_off((g) & 3, 0, 0); \
        TRRD(S##l0, b_); TRRD(S##h0, b_ + 2048); TRRD(S##l1, b_ + 4096); TRRD(S##h1, b_ + 6144); TRRD(S##l2, b_ + 8192); TRRD(S##h2, b_ + 10240); TRRD(S##l3, b_ + 12288); TRRD(S##h3, b_ + 14336); } while (0)
#define MM4(S, g) do { \
        o[g] = __builtin_amdgcn_mfma_f32_32x32x16_bf16(pa0, (bf16x8){S##l0[0], S##l0[1], S##l0[2], S##l0[3], S##h0[0], S##h0[1], S##h0[2], S##h0[3]}, o[g], 0, 0, 0); \
        o[g] = __builtin_amdgcn_mfma_f32_32x32x16_bf16(pa1, (bf16x8){S##l1[0], S##l1[1], S##l1[2], S##l1[3], S##h1[0], S##h1[1], S##h1[2], S##h1[3]}, o[g], 0, 0, 0); \
        o[g] = __builtin_amdgcn_mfma_f32_32x32x16_bf16(pa2, (bf16x8){S##l2[0], S##l2[1], S##l2[2], S##l2[3], S##h2[0], S##h2[1], S##h2[2], S##h2[3]}, o[g], 0, 0, 0); \
        o[g] = __builtin_amdgcn_mfma_f32_32x32x16_bf16(pa3, (bf16x8){S##l3[0], S##l3[1], S##l3[2], S##l3[3], S##h3[0], S##h3[1], S##h3[2], S##h3[3]}, o[g], 0, 0, 0); } while (0)
#define LW8() do { asm volatile("s_waitcnt lgkmcnt(8)" ::: "memory"); SBAR(); } while (0)
    s16x4 Al0, Al1, Al2, Al3, Ah0, Ah1, Ah2, Ah3, Bl0, Bl1, Bl2, Bl3, Bh0, Bh1, Bh2, Bh3;
    RD8(A, 0);
    RD8(B, 1); LW8(); MM4(A, 0); SBAR();
    RD8(A, 2); LW8(); MM4(B, 1); SBAR();
    RD8(B, 3); LW8(); MM4(A, 2); SBAR();
    RD8(A, 4); LW8(); MM4(B, 3); SBAR();
    RD8(B, 5); LW8(); MM4(A, 4); SBAR();
    RD8(A, 6); LW8(); MM4(B, 5); SBAR();
    RD8(B, 7); LW8(); MM4(A, 6); SBAR();
    asm volatile("s_waitcnt lgkmcnt(0)" ::: "memory"); SBAR(); MM4(B, 7);
#undef LW8
#undef MM4
#undef RD8
#undef TRRD
}

struct BlockRef { const bf16_t* Q; const bf16_t* K; const bf16_t* V; bf16_t* O; float* LSE; int rs, os, ls, P0, W, skv; };
struct Seam { bf16x8 qr[8]; bf16x8 st_v0, st_v1, st_k0, st_k1; };
__device__ __forceinline__ int swa_jlo(int P0, int W) { const int lowk = P0 - W + 1; return lowk > 0 ? lowk / KVBLK : 0; }
#define VMW() asm volatile("s_waitcnt vmcnt(0)" ::: "memory")
#define VMWN(n) asm volatile("s_waitcnt vmcnt(%0)" :: "i"(n) : "memory")
#define SLOAD_H(Kp, Vp, RS, k0) do { const bf16_t* kq_ = (Kp) + (size_t)(k0) * (RS); const bf16_t* vq_ = (Vp) + (size_t)(k0) * (RS); const int o0_ = sr * (RS) + sc, o1_ = (32 + sr) * (RS) + sc; \
                         S.st_v0 = ld8(vq_ + o0_); S.st_v1 = ld8(vq_ + o1_); S.st_k0 = ld8(kq_ + o0_); S.st_k1 = ld8(kq_ + o1_); } while (0)
#define SWRITE_HK(bf) do { *(bf16x8*)(K_lds + (bf) * SHM_K + kws) = S.st_k0; *(bf16x8*)(K_lds + (bf) * SHM_K + kws + 32 * 256) = S.st_k1; } while (0)
#define SWRITE_HV(bf) do { *(bf16x8*)(V_lds + (bf) * SHM_V + vst0) = S.st_v0; *(bf16x8*)(V_lds + (bf) * SHM_V + vst1) = S.st_v1; } while (0)
#define SWRITE_H(bf) do { SWRITE_HV(bf); SWRITE_HK(bf); } while (0)
__device__ __forceinline__ void attn_prime(const BlockRef& cur, char* lds, Seam& S) {
    int tid_ = threadIdx.x; asm volatile("" : "+v"(tid_));
    const int tid = tid_, wid = __builtin_amdgcn_readfirstlane(tid >> 6), lane = tid & 63, r32 = lane & 31, hi = lane >> 5;
    const int sr = tid >> 4, sc = (tid & 15) * 8, kws = KSWZ(sr, sc * 2); char* K_lds = lds + 2 * SHM_V;
    const int kb0 = swa_jlo(cur.P0, cur.W) * KVBLK;
    for (int d0 = 0; d0 < 8; ++d0) S.qr[d0] = ld8(cur.Q + (size_t)(wid * QBLK + r32) * cur.rs + d0 * 16 + hi * 8);
    SLOAD_H(cur.K, cur.V, cur.rs, kb0); VMW(); SWRITE_HK(0);
    __syncthreads();
}
__device__ __forceinline__ void attn_block(const BlockRef& cur, const BlockRef& nxt, char* lds, Seam& S) {
    int tid_ = threadIdx.x; asm volatile("" : "+v"(tid_));
    const int tid = tid_, wid = __builtin_amdgcn_readfirstlane(tid >> 6), lane = tid & 63, r32 = lane & 31, hi = lane >> 5;
    const int W = cur.W, skv = cur.skv, RS = cur.rs;
    const int j_lo = swa_jlo(cur.P0, W);
    int j_hi = (cur.P0 + QB - 1) / KVBLK + 1; if (j_hi > skv / KVBLK) j_hi = skv / KVBLK;
    const int NT = j_hi - j_lo;
    const int kbn = swa_jlo(nxt.P0, nxt.W) * KVBLK;
    const int qlo = cur.P0 + wid * QBLK, qm = qlo + r32 - 4 * hi;
    char* V_lds = lds; char* K_lds = lds + 2 * SHM_V;
    float* ws = (float*)(lds + 2 * SHM_V + 2 * SHM_K) + wid * 64; float* li_l = ws, * al_l = ws + 32;
    float m_reg = -1e30f, l_reg = 0; f32x16 o[4] = {};
    const int sr = tid >> 4, sc = (tid & 15) * 8, vst0 = v_st(sr, sc), vst1 = v_st(32 + sr, sc), kws = KSWZ(sr, sc * 2);
    const int vb0 = (int)(uintptr_t)V_lds + v_rd_base(lane);
    const bf16_t* Kh = cur.K; const bf16_t* Vh = cur.V;
#define RESC(a) do { if (__any((a) < 1.f)) { if (hi == 0) al_l[r32] = (a); asm volatile("s_waitcnt lgkmcnt(0)" ::: "memory");              \
                     for (int d_ = 0; d_ < 4; ++d_) for (int r = 0; r < 16; ++r) o[d_][r] *= al_l[crow(r, hi)]; } } while (0)
#define KBASE(t) ((j_lo + (t)) * KVBLK)
#define MASKT(P0_, P1_, t) do { const int kb_ = KBASE(t); if (kb_ + KVBLK - 1 > qlo || kb_ <= qlo + QBLK - 1 - W) mask_tile(P0_, P1_, qm - kb_, (unsigned)W); } while (0)
    constexpr int NQL = 8;
#define SEAM_K0() do { VMWN(NQL); SWRITE_HK(0); SBAR(); } while (0)
    f32x16 pA0, pA1, pB0, pB1; float mnA, mnB, alA, alB; bf16x8 pa0, pa1, pa2, pa3;
    SWRITE_HV(0); SBAR();
    if (NT > 1) { SLOAD_H(Kh, Vh, RS, KBASE(1)); }
    SBAR(); qkt<0>(pA0, pA1, K_lds, r32, hi, S.qr);
    MASKT(pA0, pA1, 0); partialSM(pA0, pA1, m_reg, mnA, alA);
    if (NT > 1) { VMW(); SWRITE_H(1); }
    __syncthreads();
#define HALF_STEP(PX0, PX1, mnX, alX, PY0, PY1, alY, t, KB, VB, SB) do {                                                      \
        SBAR(); qkt<KB>(PX0, PX1, K_lds, r32, hi, S.qr);                                                                      \
        finishSM(PY0, PY1, alY, l_reg, pa0, pa1, pa2, pa3); SBAR();                                                           \
        if ((t) + 1 < NT) { SLOAD_H(Kh, Vh, RS, KBASE((t) + 1)); SBAR(); }                                                    \
        pv_tile<VB>(o, vb0, pa0, pa1, pa2, pa3); MASKT(PX0, PX1, (t)); partialSM(PX0, PX1, m_reg, mnX, alX);                  \
        __syncthreads();                                                                                                      \
        if ((t) + 1 < NT) { VMW(); SWRITE_H(SB); }                                                                            \
        RESC(alX); __syncthreads(); } while (0)
    for (int t = 1; t + 1 < NT; t += 2) {
        HALF_STEP(pB0, pB1, mnB, alB, pA0, pA1, alA, t, 1, 0, 0);
        HALF_STEP(pA0, pA1, mnA, alA, pB0, pB1, alB, t + 1, 0, 1, 1);
    }
    const bool even = (NT & 1) == 0;
    if (even) { SBAR(); qkt<1>(pB0, pB1, K_lds, r32, hi, S.qr); SBAR(); }
    SLOAD_H(nxt.K, nxt.V, nxt.rs, kbn); SBAR();
#pragma unroll
    for (int d0 = 0; d0 < 8; ++d0) S.qr[d0] = ld8(nxt.Q + (size_t)(wid * QBLK + r32) * nxt.rs + d0 * 16 + hi * 8);
    SBAR();
    finishSM(pA0, pA1, alA, l_reg, pa0, pa1, pa2, pa3); SBAR();
    pv_tile<0>(o, vb0, pa0, pa1, pa2, pa3);
    if (even) { MASKT(pB0, pB1, NT - 1); partialSM(pB0, pB1, m_reg, mnB, alB); __syncthreads(); RESC(alB);
        finishSM(pB0, pB1, alB, l_reg, pa0, pa1, pa2, pa3); SBAR(); pv_tile<1>(o, vb0, pa0, pa1, pa2, pa3); }
    SBAR(); SEAM_K0();
    if (hi == 0) li_l[r32] = l_reg; asm volatile("s_waitcnt lgkmcnt(0)" ::: "memory");
    if (cur.LSE && hi == 0) cur.LSE[(size_t)(wid * QBLK + r32) * cur.ls] = m_reg * SCALE + __logf(l_reg);
    float rli[16];
#pragma unroll
    for (int r = 0; r < 16; ++r) rli[r] = __builtin_amdgcn_rcpf(li_l[crow(r, hi)]);
    bf16_t* Ow = cur.O + (size_t)(wid * QBLK) * cur.os;
#pragma unroll
    for (int r = 0; r < 16; ++r) { const int orow = crow(r, hi);
#pragma unroll
        for (int d0 = 0; d0 < 4; ++d0) { const float v = o[d0][r] * rli[r];
            const float vn = __shfl_xor(v, 1);
            if ((r32 & 1) == 0) *(unsigned*)(Ow + (size_t)orow * cur.os + d0 * 32 + r32) = cvtpk(v, vn); } }
    __syncthreads();
#undef RESC
#undef KBASE
#undef MASKT
#undef SEAM_K0
#undef HALF_STEP
}

struct WideRef { const bf16_t* Q; const bf16_t* K; const bf16_t* V; bf16_t* O; int rs, os, P0; };
constexpr int WIDE_K_OFF = 98304, WIDE_WS_OFF = 131072, WIDE_LDS_BYTES = WIDE_WS_OFF + NW * 64 * 4;
#define ATT_LAS __attribute__((address_space(3)))
__device__ __forceinline__ void attn_wide_block(const WideRef& cur, char* lds, ATT_LAS unsigned char* ldsl) {
    int tid_ = threadIdx.x; asm volatile("" : "+v"(tid_));
    const int tid = tid_, wid = __builtin_amdgcn_readfirstlane(tid >> 6), lane = tid & 63, r32 = lane & 31, hi = lane >> 5;
    const bool grpB = wid >= 4;
    const int RS = cur.rs;
    const int NT = cur.P0 / KVBLK + QB / KVBLK;
    const int qlo = cur.P0 + wid * QBLK, qm = qlo + r32 - 4 * hi;
    char* V_lds = lds; char* K_lds = lds + WIDE_K_OFF;
    float* ws = (float*)(lds + WIDE_WS_OFF) + wid * 64; float* li_l = ws, * al_l = ws + 32;
    const int vb0 = (int)(uintptr_t)V_lds + v_rd_base(lane);
    const int L = wid * 1024 + lane * 16;
    const int krow = L >> 8, kcol = ((L & 255) ^ ((krow & 7) << 4)) >> 1;
    const int vsub = L >> 9, vkk = (vsub >> 2) * 8 + ((L & 511) >> 6), vcol = (vsub & 3) * 32 + ((L & 63) >> 1);
    const int vkey = (vkk & ~0xC) | ((vkk & 4) << 1) | ((vkk & 8) >> 1);
    const unsigned offK = (unsigned)(krow * RS + kcol) * 2u, offV = (unsigned)(vkey * RS + vcol) * 2u;
    const size_t half32 = (size_t)32 * RS * 2;
    bf16x8 qr[8];
#pragma unroll
    for (int d0 = 0; d0 < 8; ++d0) qr[d0] = ld8(cur.Q + (size_t)(wid * QBLK + r32) * RS + d0 * 16 + hi * 8);
#define WDMA1(gp, ldsoff) __builtin_amdgcn_global_load_lds((const unsigned*)(gp), (ATT_LAS unsigned*)(ldsl + (ldsoff) + wid * 1024), 16, 0, 0)
#define WDMA(k0, kb, vb) do { const char* kq_ = (const char*)(cur.K + (size_t)(k0) * RS); const char* vq_ = (const char*)(cur.V + (size_t)(k0) * RS); \
        const int ko_ = WIDE_K_OFF + (kb) * SHM_K, vo_ = (vb) * 32768; \
        WDMA1(kq_ + offK, ko_); WDMA1(kq_ + half32 + offK, ko_ + 8192); \
        WDMA1(vq_ + offV, vo_); WDMA1(vq_ + half32 + offV, vo_ + 8192); \
        WDMA1(vq_ + 256 + offV, vo_ + 16384); WDMA1(vq_ + 256 + half32 + offV, vo_ + 16384 + 8192); } while (0)
    WDMA(0, 0, 0); asm volatile("s_waitcnt vmcnt(0)" ::: "memory");
    __syncthreads();
    float m_reg = -1e30f, l_reg = 0; f32x16 o[8] = {};
    bf16x8 pa0 = {}, pa1 = {}, pa2 = {}, pa3 = {};
    int v3 = 0;
#define WQK(t) do { f32x16 p0, p1; float mn, al; \
        qkt<0>(p0, p1, K_lds + ((t) & 1) * SHM_K, r32, hi, qr); \
        { const int kb_ = (t) * KVBLK; if (kb_ + KVBLK - 1 > qlo) mask_tile(p0, p1, qm - kb_, 1u << 30); } \
        partialSM(p0, p1, m_reg, mn, al); finishSM(p0, p1, al, l_reg, pa0, pa1, pa2, pa3); SBAR(); \
        if (__any(al < 1.f)) { if (hi == 0) al_l[r32] = al; asm volatile("s_waitcnt lgkmcnt(0)" ::: "memory"); \
            _Pragma("unroll") for (int d_ = 0; d_ < 8; ++d_) _Pragma("unroll") for (int r = 0; r < 16; ++r) o[d_][r] *= al_l[crow(r, hi)]; } } while (0)
#define WPV(vbuf) do { const int vbt_ = vb0 + (vbuf) * 32768; pv_tile<0, 16384>(o, vbt_, pa0, pa1, pa2, pa3); pv_tile<1, 16384>(o + 4, vbt_, pa0, pa1, pa2, pa3); SBAR(); } while (0)
    for (int t = 0; t < NT; ++t) {
        const int v3n = v3 == 2 ? 0 : v3 + 1, v3p = v3 == 0 ? 2 : v3 - 1;
        if (t + 1 < NT) { WDMA((t + 1) * KVBLK, (t + 1) & 1, v3n); } SBAR();
        if (grpB && t > 0) { WPV(v3p); }
        WQK(t);
        if (!grpB) { WPV(v3); }
        asm volatile("s_waitcnt vmcnt(0)" ::: "memory");
        __syncthreads();
        v3 = v3n;
    }
    if (grpB) { const int v3p = v3 == 0 ? 2 : v3 - 1; WPV(v3p); }
#undef WQK
#undef WPV
#undef WDMA
#undef WDMA1
    if (hi == 0) li_l[r32] = l_reg; asm volatile("s_waitcnt lgkmcnt(0)" ::: "memory");
    float rli[16];
#pragma unroll
    for (int r = 0; r < 16; ++r) rli[r] = __builtin_amdgcn_rcpf(li_l[crow(r, hi)]);
    bf16_t* Ow = cur.O + (size_t)(wid * QBLK) * cur.os;
#pragma unroll
    for (int r = 0; r < 16; ++r) { const int orow = crow(r, hi);
#pragma unroll
        for (int d0 = 0; d0 < 8; ++d0) { const float v = o[d0][r] * rli[r];
            const float vn = __shfl_xor(v, 1);
            if ((r32 & 1) == 0) *(unsigned*)(Ow + (size_t)orow * cur.os + d0 * 32 + r32) = cvtpk(v, vn); } }
    __syncthreads();
}
#undef VMW
#undef VMWN
#undef SLOAD_H
#undef SWRITE_HK
#undef SWRITE_HV
#undef SWRITE_H
}

#define GAS __attribute__((address_space(1)))
#define LAS __attribute__((address_space(3)))
typedef unsigned short bf16;
typedef unsigned v4u __attribute__((ext_vector_type(4)));
typedef unsigned v2u __attribute__((ext_vector_type(2)));
typedef float f32x4 __attribute__((ext_vector_type(4)));
#define LDS_WAIT() asm volatile("s_waitcnt lgkmcnt(0)" ::: "memory")
__device__ __forceinline__ unsigned f2bf(float f) { unsigned u = __builtin_bit_cast(unsigned, f); return (u + 0x7fffu + ((u >> 16) & 1u)) >> 16; }
__device__ __forceinline__ unsigned pk2(float lo, float hi) { return f2bf(lo) | (f2bf(hi) << 16); }
__device__ __forceinline__ float bflo(unsigned w) { return __uint_as_float(w << 16); }
__device__ __forceinline__ float bfhi(unsigned w) { return __uint_as_float(w & 0xffff0000u); }

#define XB_TMO      128
#define XB_XCNT(j)  (256  + 64 * (j))
#define XB_XSUB(j)  (1280 + 64 * (j))
#define XB_XGEN(j)  (2304 + 64 * (j))
#define XB_TOP      3328
#define XB_TOPGEN   3392
#define XCD_BAR_WORDS 3456
#define XB_SPIN_CAP (1u << 18)

__device__ __forceinline__ unsigned xb_ld(unsigned* p)              { return __hip_atomic_load(p, __ATOMIC_RELAXED, __HIP_MEMORY_SCOPE_AGENT); }
__device__ __forceinline__ unsigned xb_add(unsigned* p, unsigned v) { return __hip_atomic_fetch_add(p, v, __ATOMIC_RELAXED, __HIP_MEMORY_SCOPE_AGENT); }
__device__ __forceinline__ unsigned xb_xcc_id() { return (unsigned)__builtin_amdgcn_s_getreg((3 << 11) | 20) & 0xFu; }
#define XB_SPIN(cond, bar) do { unsigned _sp = 0; while (cond) { __builtin_amdgcn_s_sleep(1); \
    if ((++_sp & 255u) == 0u) { if (xb_ld(&(bar)[XB_TMO])) break; if (_sp > XB_SPIN_CAP) { atomicAdd(&(bar)[XB_TMO], 1u); break; } } } } while (0)

struct XcdBarrier {
    unsigned* bar; unsigned x;
    volatile LAS unsigned* st;
};

__device__ __forceinline__ XcdBarrier xcd_barrier_post(unsigned* bar, volatile LAS unsigned* st) {
    XcdBarrier b; b.bar = bar; b.x = xb_xcc_id(); b.st = st;
    if (threadIdx.x == 0) (void)xb_add(&bar[XB_XCNT(b.x)], 1u);
    return b;
}
__device__ __forceinline__ void xcd_barrier_complete(unsigned* bar, unsigned x, unsigned& nloc, unsigned& nx) {
    const unsigned G = gridDim.x * gridDim.y * gridDim.z;
    unsigned sum, cnt, mine, sp = 0u;
    for (;;) {
        sum = 0u; cnt = 0u; mine = 0u;
#pragma unroll
        for (unsigned j = 0; j < 16; ++j) { const unsigned c = xb_ld(&bar[XB_XCNT(j)]); sum += c; cnt += (c > 0u) ? 1u : 0u; mine = (j == x) ? c : mine; }
        if (sum == G) break;
        __builtin_amdgcn_s_sleep(1);
        if ((++sp & 255u) == 0u) { if (xb_ld(&bar[XB_TMO])) break; if (sp > XB_SPIN_CAP) { atomicAdd(&bar[XB_TMO], 1u); break; } }
    }
    nloc = mine > 0u ? mine : 1u; nx = cnt > 0u ? cnt : 1u;
}

__device__ __forceinline__ void xcd_barrier(const XcdBarrier& b) {
    asm volatile("s_waitcnt vmcnt(0)" ::: "memory");
    __syncthreads();
    if (threadIdx.x == 0) {
        unsigned* bar = b.bar;
        __builtin_amdgcn_s_waitcnt(0);
        unsigned nloc = b.st[0], nx = b.st[1];
        if (nloc == 0u) { xcd_barrier_complete(bar, b.x, nloc, nx); b.st[0] = nloc; b.st[1] = nx; }
        const unsigned old = xb_add(&bar[XB_XSUB(b.x)], 1u);
        const unsigned gen = old / nloc;
        if (old + 1u == (gen + 1u) * nloc) {
            __builtin_amdgcn_fence(__ATOMIC_RELEASE, "agent");
            asm volatile("s_waitcnt vmcnt(0)" ::: "memory");
            const unsigned og = xb_add(&bar[XB_TOP], 1u);
            const unsigned tg = og / nx;
            if (og + 1u == (tg + 1u) * nx) xb_add(&bar[XB_TOPGEN], 1u);
            else XB_SPIN(xb_ld(&bar[XB_TOPGEN]) == tg, bar);
            __builtin_amdgcn_fence(__ATOMIC_ACQUIRE, "agent");
            xb_add(&bar[XB_XGEN(b.x)], 1u);
            asm volatile("s_waitcnt vmcnt(0)" ::: "memory");
        } else {
            XB_SPIN(xb_ld(&bar[XB_XGEN(b.x)]) == gen, bar);
            __builtin_amdgcn_fence(__ATOMIC_ACQUIRE, "agent");
            asm volatile("s_waitcnt vmcnt(0)" ::: "memory");
        }
    }
    __syncthreads();
}
constexpr int NB = 4, SEQ = 4096, DM = 2048, M = NB * SEQ, DFF = 5632, NQKV = 7680, NGATE = 4096, DIN = NQKV + NGATE;
constexpr int NWAVES = 8;
constexpr float RMS_EPS = 1e-6f;
constexpr float LAM_INIT = 0.2f;
constexpr size_t MiB = 1u << 20;
constexpr size_t WS_QKV = 0, WS_GATES = 240 * MiB;
constexpr size_t WS_W1GU = 0, WS_W1D = 44 * MiB, WS_HID = 66 * MiB;
constexpr size_t WS_XB = 368 * MiB;
constexpr size_t WS_WIN = 432 * MiB;
constexpr size_t WS_ODIL_RAW = 432 * MiB;
constexpr size_t WS_LSE = 480 * MiB;
constexpr size_t WS_SS = 481 * MiB;
constexpr size_t WS_ROPE = 482 * MiB;
constexpr size_t WS_WOUT = 484 * MiB, WS_WDIL = 492 * MiB, WS_WDIFF = 494 * MiB;
constexpr size_t WS_W2GU = 0, WS_W2D = 44 * MiB, WS_ODIL = 66 * MiB, WS_ODIFF = 82 * MiB, WS_Y = 114 * MiB;
constexpr size_t WS_HID2 = 66 * MiB;
constexpr size_t WS_BAR = 498 * MiB, WS_BAR_BYTES = 16384;
constexpr size_t WS_END = 499 * MiB;
constexpr int LDS_MISC = 139264, LDS_BYTES = LDS_MISC + 256;

__device__ __forceinline__ float wave_sum(float v) {
#pragma unroll
    for (int o = 1; o < 64; o <<= 1) v += __shfl_xor(v, o);
    return v;
}
__device__ __forceinline__ unsigned cvtpk2(float lo, float hi) { unsigned r; asm volatile("v_cvt_pk_bf16_f32 %0, %1, %2" : "=v"(r) : "v"(lo), "v"(hi)); return r; }
__device__ __forceinline__ void transpose_mat(const float* W, int K, int N, const float* gain, bf16* WT, int mode, int gw, int NGW, int lane, int& ibase, LAS float* scr, int blk = 0, int ldk = 0, int koff = 0) {
    const int nkb = K / 64, nit = nkb * (N / 64);
    const int it0 = (gw - ibase % NGW + NGW) % NGW; ibase += nit;
    const int ln = (lane & 15) * 4, lk = lane >> 4, c = lane & 7, ns = lane >> 3;
    for (int it = it0; it < nit; it += NGW) {
        const int nb = it / nkb, kb = it - nb * nkb, k0 = kb * 64, n0 = nb * 64;
        const float* src = W + (size_t)(k0 + lk) * N + n0 + ln;
        f32x4 v[16];
#pragma unroll
        for (int i = 0; i < 16; ++i) v[i] = __builtin_nontemporal_load((const f32x4*)(src + (size_t)(4 * i) * N));
        if (gain) {
#pragma unroll
            for (int i = 0; i < 16; ++i) v[i] = v[i] * gain[k0 + 4 * i + lk];
        }
#pragma unroll
        for (int i = 0; i < 16; ++i) { LAS float* d = scr + (4 * i + lk) * 65 + ln; d[0] = v[i][0]; d[1] = v[i][1]; d[2] = v[i][2]; d[3] = v[i][3]; }
        LDS_WAIT(); asm volatile("" ::: "memory");
#pragma unroll
        for (int jj = 0; jj < 8; ++jj) { const int nl = ns + 8 * jj, n = n0 + nl; const LAS float* s = scr + (8 * c) * 65 + nl;
            const int row = mode == 0 ? n : ((n >> 7) * 256 + (mode == 2 ? 128 : 0) + (n & 127));
            v4u o; o.x = cvtpk2(s[0 * 65], s[1 * 65]); o.y = cvtpk2(s[2 * 65], s[3 * 65]); o.z = cvtpk2(s[4 * 65], s[5 * 65]); o.w = cvtpk2(s[6 * 65], s[7 * 65]);
            bf16* dst = blk ? WT + (size_t)(k0 >> 6) * ((size_t)blk * 64) + (size_t)row * 64 + 8 * c : WT + (size_t)row * (ldk ? ldk : K) + koff + k0 + 8 * c;
            *(v4u*)dst = o; }
        LDS_WAIT(); asm volatile("" ::: "memory");
    }
}

#ifndef PG_ALIGN_BIG
#define PG_ALIGN_BIG true
#endif
struct Args { const float* in[24]; float* out; unsigned char* ws; int ph_lo, ph_hi; };
constexpr int NPHASE = 11;

__device__ __forceinline__ att::BlockRef attn_decode(int s, int w, int G, int nd, bf16* qkv, bf16* odiff_raw, bf16* odil_raw, float* lse) {
    att::BlockRef r;
    if (s < 2 * nd) {
        const int item = w + (s >> 1) * G, pass = s & 1, head = item >> 3, y = item & 7, qb = pass ? 15 - y : y;
        const int vh = head & 1, comp = (head >> 1) & 1, h = (head >> 2) & 3, b = head >> 4;
        bf16* base = qkv + (size_t)(b * SEQ) * NQKV;
        r.Q = base + 4608 + h * 256 + comp * 128 + (size_t)(qb * 256) * NQKV;
        r.K = base + 5632 + h * 256 + comp * 128;
        r.V = base + 6656 + h * 256 + vh * 128;
        r.O = odiff_raw + (size_t)comp * ((size_t)M * 1024) + (size_t)(b * SEQ + qb * 256) * 1024 + h * 256 + vh * 128;
        r.LSE = nullptr; r.rs = NQKV; r.os = 1024; r.ls = 0; r.P0 = qb * 256; r.W = 1 << 30; r.skv = SEQ;
    } else {
        const int blk = w + (s - 2 * nd) * G, g = blk >> 8, rem = blk & 255;
        const int dil = g == 0 ? 1 : (g == 1 ? 4 : 16), L = SEQ / dil, nqb = L / 256;
        const int qb = rem % nqb; int t = rem / nqb; const int c = t % dil; t /= dil; const int h = t & 3, b = t >> 2;
        const size_t tok0 = (size_t)b * SEQ + c;
        bf16* base = qkv + tok0 * NQKV + g * 512 + h * 128;
        r.Q = base + (size_t)(qb * 256) * ((size_t)dil * NQKV);
        r.K = base + 1536;
        r.V = base + 3072;
        r.O = odil_raw + (size_t)g * ((size_t)M * 512) + tok0 * 512 + h * 128 + (size_t)(qb * 256) * ((size_t)dil * 512);
        r.LSE = lse + (size_t)g * ((size_t)M * 4) + tok0 * 4 + h + (size_t)(qb * 256) * ((size_t)dil * 4);
        r.rs = dil * NQKV; r.os = dil * 512; r.ls = dil * 4; r.P0 = qb * 256; r.W = 129; r.skv = L;
    }
    return r;
}

__global__ void __launch_bounds__(NWAVES * 64, 2) layer_fwd(Args args) {
    extern __shared__ __attribute__((aligned(16))) unsigned char lds[];
    const int wave = __builtin_amdgcn_readfirstlane((int)threadIdx.x >> 6);
#define PHASE_TID() int tid_ = threadIdx.x; asm volatile("" : "+v"(tid_)); const int tid = tid_, lane = tid & 63; (void)lane
    const int G = gridDim.x, bx = blockIdx.x;
    const int vcu = (G % 8 == 0) ? (bx % 8) * (G / 8) + bx / 8 : bx;
    const int gw = vcu * NWAVES + wave, NGW = G * NWAVES;
    const int NTHR = G * NWAVES * 64;
    unsigned char* ws = args.ws;
    LAS unsigned char* ldsl = (LAS unsigned char*)lds;
    const int lo = args.ph_lo, hi = args.ph_hi;
#ifndef PHASE_MASK
#define PHASE_MASK 0x7ff
#endif
#define IN(k) (((PHASE_MASK >> (k)) & 1) && lo <= (k) && (k) < hi)
    volatile LAS unsigned* MISC = (volatile LAS unsigned*)(ldsl + LDS_MISC);
    if (threadIdx.x < 64) MISC[threadIdx.x] = 0u;
    __syncthreads();
    XcdBarrier bar = xcd_barrier_post((unsigned*)(ws + WS_BAR), MISC + 8);
#define SEAM(k) do { if (IN(k) && IN((k) + 1)) { if ((k) == 0) { asm volatile("s_waitcnt vmcnt(0)" ::: "memory"); cg::this_grid().sync(); } else xcd_barrier(bar); } STAMP(k); } while (0)
#ifndef PROBE_MASK
#define PROBE_MASK 0
#endif
#if PROBE_MASK
    unsigned long long t_prev = __builtin_amdgcn_s_memrealtime(), t_acc = 0; unsigned kl_save = 0; (void)kl_save;
#define STAMP(k) do { const unsigned long long t_now = __builtin_amdgcn_s_memrealtime(); if ((PROBE_MASK >> (k)) & 1) t_acc += t_now - t_prev; t_prev = t_now; } while (0)
#else
#define STAMP(k) do { } while (0)
#endif
    const float* x = args.in[0]; float* out = args.out;
    bf16* XB = (bf16*)(ws + WS_XB); bf16* HID = (bf16*)(ws + WS_HID); bf16* QKV = (bf16*)(ws + WS_QKV); bf16* GATES = (bf16*)(ws + WS_GATES);
    float* SS1 = (float*)(ws + WS_SS); float* SS2 = SS1 + M; float* SS3 = SS2 + M;
    float* COS = (float*)(ws + WS_ROPE); float* SIN = COS + (size_t)M * 16;
    float* LSE = (float*)(ws + WS_LSE);
    bf16* W2GU = (bf16*)out + (size_t)32 * 1024 * 1024;
    const int nwg3 = (M / 256) * (DIN / 256), rounds3 = (nwg3 + G - 1) / G, first_idle3 = nwg3 - (rounds3 - 1) * G;
    const bool w2gu_in_p3 = first_idle3 < G;
    bf16* ODIFF_RAW = (bf16*)out;     bf16* ODIL_RAW = (bf16*)(ws + WS_ODIL_RAW);
    bf16* ODIL = (bf16*)(ws + WS_ODIL); bf16* ODIFF = (bf16*)(ws + WS_ODIFF); bf16* Y = (bf16*)(ws + WS_Y);

    if (IN(0)) {
        PHASE_TID(); const int gtid = bx * (NWAVES * 64) + tid;
        int ibase = 0; LAS float* scr = (LAS float*)(ldsl + wave * 16640);
        transpose_mat(args.in[3], DM, DFF, args.in[2], (bf16*)(ws + WS_W1GU), 1, gw, NGW, lane, ibase, scr);
        transpose_mat(args.in[4], DM, DFF, args.in[2], (bf16*)(ws + WS_W1GU), 2, gw, NGW, lane, ibase, scr);
        transpose_mat(args.in[5], DFF, DM, nullptr, (bf16*)(ws + WS_W1D), 0, gw, NGW, lane, ibase, scr);
        transpose_mat(args.in[7], DM, DIN, args.in[6], (bf16*)(ws + WS_WIN), 0, gw, NGW, lane, ibase, scr);
        transpose_mat(args.in[17], 512, DM, nullptr, (bf16*)(ws + WS_WDIL), 0, gw, NGW, lane, ibase, scr, 0, 1536, 0);
        transpose_mat(args.in[18], 1024, DM, nullptr, (bf16*)(ws + WS_WDIL), 0, gw, NGW, lane, ibase, scr, 0, 1536, 512);
        transpose_mat(args.in[19], DM, DM, nullptr, (bf16*)(ws + WS_WOUT), 0, gw, NGW, lane, ibase, scr);
        for (int m = gw; m < M; m += NGW) {
            const f32x4* xr = (const f32x4*)(x + (size_t)m * DM) + lane; f32x4 v[8]; float s = 0.f;
#pragma unroll
            for (int j = 0; j < 8; ++j) { v[j] = __builtin_nontemporal_load(xr + 64 * j); s += (v[j].x * v[j].x + v[j].y * v[j].y) + (v[j].z * v[j].z + v[j].w * v[j].w); }
            s = wave_sum(s); if (lane == 0) SS1[m] = s;
            v2u* o8 = (v2u*)(XB + (size_t)m * DM) + lane;
#pragma unroll
            for (int j = 0; j < 8; ++j) { v2u w; w.x = pk2(v[j].x, v[j].y); w.y = pk2(v[j].z, v[j].w); o8[64 * j] = w; }
        }
        for (int i = gtid; i < 2 * M; i += NTHR) SS2[i] = 0.f;
        const int* pos = (const int*)args.in[1];
        for (int idx = gtid; idx < M * 16; idx += NTHR) { const int t = idx >> 4, i = idx & 15;
            const float inv = __builtin_amdgcn_exp2f((float)i * (-1.0f / 16.0f) * 18.931568569324174f);
            const float ang = (float)pos[t] * inv;
            const double rev = (double)ang * 0.15915494309189535; const float fr = (float)(rev - __builtin_rint(rev));
            COS[idx] = __builtin_amdgcn_cosf(fr); SIN[idx] = __builtin_amdgcn_sinf(fr); }
    }
    SEAM(0);
#ifdef PROBE_KLOOP
    if (PROBE_KLOOP == 1 && threadIdx.x == 0) MISC[16] = 0u;
#endif
    if (IN(1)) {
        pg8::Gemm g{XB, (bf16*)(ws + WS_W1GU), M, 2 * DFF, DM}; pg8::StaticOrder So; So.init(M, 2 * DFF, G, bx, 4);
        pg8::EpiSwiglu<false> E{HID, DFF, SS1, M};
        pg8::gemm_phase<pg8::EpiSwiglu<false>, pg8::StaticOrder, PG_ALIGN_BIG, true>(ldsl, g, So, E);
    }
    SEAM(1);
#ifdef PROBE_KLOOP
    if (PROBE_KLOOP == 1 && threadIdx.x == 0) { kl_save = MISC[16]; }
#endif
    if (IN(2)) {
        pg8::Gemm g{HID, (bf16*)(ws + WS_W1D), M, DM, DFF}; pg8::StaticOrder So; So.init(M, DM, G, bx, 4);
        pg8::EpiResid<true, false, false> E{x, nullptr, XB, SS2, 0.5f, DM};
        pg8::gemm_phase<pg8::EpiResid<true, false, false>, pg8::StaticOrder, true, true>(ldsl, g, So, E);
    }
    SEAM(2);
    if (IN(3)) {
        pg8::Gemm g{XB, (bf16*)(ws + WS_WIN), M, DIN, DM}; pg8::StaticOrder So; So.init(M, DIN, G, bx, 4);
        pg8::EpiProj E{QKV, NQKV, GATES, NGATE, NQKV / 256, SS2, args.in[8], args.in[9], args.in[10], args.in[11], COS, SIN, (LAS float*)(ldsl + 131072)};
        pg8::gemm_phase<pg8::EpiProj, pg8::StaticOrder, true, true>(ldsl, g, So, E);
        if (w2gu_in_p3 && bx >= first_idle3) {
            PHASE_TID(); const int gwi = (bx - first_idle3) * NWAVES + wave, NGWI = (G - first_idle3) * NWAVES; int ibase = 0; LAS float* scr = (LAS float*)(ldsl + wave * 16640);
            transpose_mat(args.in[21], DM, DFF, args.in[20], W2GU, 1, gwi, NGWI, lane, ibase, scr);
            transpose_mat(args.in[22], DM, DFF, args.in[20], W2GU, 2, gwi, NGWI, lane, ibase, scr);
        }
    }
    SEAM(3);
    if (IN(5)) {
        const int w = vcu;
        for (int i = w; i < 256; i += G) {
            const int head = i >> 3, y = i & 7, comp = head & 1, h = (head >> 1) & 3, b = head >> 3;
            bf16* base = QKV + (size_t)(b * SEQ) * NQKV;
            for (int pass = 0; pass < 2; ++pass) { const int qb = pass ? y : 15 - y;
                att::WideRef r; r.Q = base + 4608 + h * 256 + comp * 128 + (size_t)(qb * 256) * NQKV; r.K = base + 5632 + h * 256 + comp * 128; r.V = base + 6656 + h * 256;
                r.O = ODIFF_RAW + (size_t)comp * ((size_t)M * 1024) + (size_t)(b * SEQ + qb * 256) * 1024 + h * 256; r.rs = NQKV; r.os = 1024; r.P0 = qb * 256;
                att::attn_wide_block(r, (char*)lds, ldsl); }
        }
        const int nd = 0, ndl = w < 768 ? (768 - w + G - 1) / G : 0, total = ndl;
        if (total > 0) {
            att::Seam S;
            { const att::BlockRef c0 = attn_decode(0, w, G, nd, QKV, ODIFF_RAW, ODIL_RAW, LSE); att::attn_prime(c0, (char*)lds, S); }
            for (int s = 0; s < total; ++s) {
                const att::BlockRef cur = attn_decode(s, w, G, nd, QKV, ODIFF_RAW, ODIL_RAW, LSE);
                const att::BlockRef nxt = attn_decode(s + 1 < total ? s + 1 : s, w, G, nd, QKV, ODIFF_RAW, ODIL_RAW, LSE);
                att::attn_block(cur, nxt, (char*)lds, S);
            }
        }
    }
    SEAM(5);
    if (IN(6)) {
        PHASE_TID();
        int ibase = 0; LAS float* scr = (LAS float*)(ldsl + wave * 16640);
        if (!w2gu_in_p3) {
            transpose_mat(args.in[21], DM, DFF, args.in[20], W2GU, 1, gw, NGW, lane, ibase, scr);
            transpose_mat(args.in[22], DM, DFF, args.in[20], W2GU, 2, gw, NGW, lane, ibase, scr);
        }
        transpose_mat(args.in[23], DFF, DM, nullptr, (bf16*)(ws + WS_W2D), 0, gw, NGW, lane, ibase, scr);
        float lam;
        { const float a = args.in[12][lane] * args.in[13][lane] + args.in[12][lane + 64] * args.in[13][lane + 64];
          const float b = args.in[14][lane] * args.in[15][lane] + args.in[14][lane + 64] * args.in[15][lane + 64];
          lam = __expf(wave_sum(a)) - __expf(wave_sum(b)) + LAM_INIT; }
        const float* subln = args.in[16];
        for (int t = gw; t < M; t += NGW) {
            {
                const int h = lane >> 4;
                const float l0 = LSE[(size_t)t * 4 + h], l1 = LSE[(size_t)M * 4 + (size_t)t * 4 + h], l2 = LSE[(size_t)M * 8 + (size_t)t * 4 + h];
                const float mx = fmaxf(l0, fmaxf(l1, l2)); const float e0 = __expf(l0 - mx), e1 = __expf(l1 - mx), e2 = __expf(l2 - mx); const float inv = 1.0f / (e0 + e1 + e2);
                const float w0 = e0 * inv, w1 = e1 * inv, w2 = e2 * inv;
                const size_t off = (size_t)t * 512 + lane * 8, offo = (size_t)t * 1536 + lane * 8;
                const v4u a = __builtin_nontemporal_load((const v4u*)(ODIL_RAW + off)), b = __builtin_nontemporal_load((const v4u*)(ODIL_RAW + (size_t)M * 512 + off)), c = __builtin_nontemporal_load((const v4u*)(ODIL_RAW + (size_t)M * 1024 + off));
                v4u o;
                o.x = pk2(w0 * bflo(a.x) + w1 * bflo(b.x) + w2 * bflo(c.x), w0 * bfhi(a.x) + w1 * bfhi(b.x) + w2 * bfhi(c.x));
                o.y = pk2(w0 * bflo(a.y) + w1 * bflo(b.y) + w2 * bflo(c.y), w0 * bfhi(a.y) + w1 * bfhi(b.y) + w2 * bfhi(c.y));
                o.z = pk2(w0 * bflo(a.z) + w1 * bflo(b.z) + w2 * bflo(c.z), w0 * bfhi(a.z) + w1 * bfhi(b.z) + w2 * bfhi(c.z));
                o.w = pk2(w0 * bflo(a.w) + w1 * bflo(b.w) + w2 * bflo(c.w), w0 * bfhi(a.w) + w1 * bfhi(b.w) + w2 * bfhi(c.w));
                *(v4u*)(ODIL + offo) = o;
            }
#pragma unroll
            for (int hh = 0; hh < 2; ++hh) {
                const int l32 = lane & 31;
                const size_t off = (size_t)t * 1024 + (size_t)(hh * 2 + (lane >> 5)) * 256 + l32 * 8;
                const v4u a = __builtin_nontemporal_load((const v4u*)(ODIFF_RAW + off)), b = __builtin_nontemporal_load((const v4u*)(ODIFF_RAW + (size_t)M * 1024 + off));
                float d[8] = {bflo(a.x) - lam * bflo(b.x), bfhi(a.x) - lam * bfhi(b.x), bflo(a.y) - lam * bflo(b.y), bfhi(a.y) - lam * bfhi(b.y),
                              bflo(a.z) - lam * bflo(b.z), bfhi(a.z) - lam * bfhi(b.z), bflo(a.w) - lam * bflo(b.w), bfhi(a.w) - lam * bfhi(b.w)};
                float s = 0.f;
#pragma unroll
                for (int i = 0; i < 8; ++i) s += d[i] * d[i];
                s += __shfl_xor(s, 1); s += __shfl_xor(s, 2); s += __shfl_xor(s, 4); s += __shfl_xor(s, 8); s += __shfl_xor(s, 16);
                const float rs = rsqrtf(s * (1.0f / 256.0f) + RMS_EPS) * (1.0f - LAM_INIT);
                const f32x4 g0 = *(const f32x4*)(subln + l32 * 8), g1 = *(const f32x4*)(subln + l32 * 8 + 4);
                v4u o; o.x = pk2(d[0] * rs * g0[0], d[1] * rs * g0[1]); o.y = pk2(d[2] * rs * g0[2], d[3] * rs * g0[3]);
                o.z = pk2(d[4] * rs * g1[0], d[5] * rs * g1[1]); o.w = pk2(d[6] * rs * g1[2], d[7] * rs * g1[3]);
                *(v4u*)(ODIL + (size_t)t * 1536 + 512 + (size_t)(hh * 2 + (lane >> 5)) * 256 + l32 * 8) = o;
            }
        }
    }
    SEAM(6);
    if (IN(7)) {
        pg8::Gemm g{ODIL, (bf16*)(ws + WS_WDIL), M, DM, 1536}; pg8::StaticOrder So; So.init(M, DM, G, bx, 4);
        pg8::EpiGateMerge E{GATES, NGATE, Y, DM, 512 / 64};
        pg8::gemm_phase<pg8::EpiGateMerge, pg8::StaticOrder, true, true>(ldsl, g, So, E);
    }
    SEAM(7);
    if (IN(8)) {
        pg8::Gemm g{Y, (bf16*)(ws + WS_WOUT), M, DM, DM}; pg8::StaticOrder So; So.init(M, DM, G, bx, 4);
        pg8::EpiResid<false, false> E{XB, nullptr, XB, SS3, 1.0f, DM};
        pg8::gemm_phase<pg8::EpiResid<false, false>, pg8::StaticOrder, true, true>(ldsl, g, So, E);
    }
    SEAM(8);
    if (IN(9)) {
        pg8::Gemm g{XB, W2GU, M, 2 * DFF, DM}; pg8::StaticOrder So; So.init(M, 2 * DFF, G, bx, 4);
        pg8::EpiSwiglu<false> E{(bf16*)(ws + WS_HID2), DFF, SS3, M};
        pg8::gemm_phase<pg8::EpiSwiglu<false>, pg8::StaticOrder, PG_ALIGN_BIG, true>(ldsl, g, So, E);
    }
    SEAM(9);
#ifdef PROBE_KLOOP
    if (PROBE_KLOOP == 10 && threadIdx.x == 0) MISC[16] = 0u;
#endif
    if (IN(10)) {
        pg8::Gemm g{(bf16*)(ws + WS_HID2), (bf16*)(ws + WS_W2D), M, DM, DFF}; pg8::StaticOrder So; So.init(M, DM, G, bx, 4);
        pg8::EpiResid<false, true, false> E{XB, out, nullptr, nullptr, 0.5f, DM};
        pg8::gemm_phase<pg8::EpiResid<false, true, false>, pg8::StaticOrder, true, true>(ldsl, g, So, E);
    }
    STAMP(10);
#ifdef PROBE_KLOOP
    t_acc = 0; if (threadIdx.x == 0) t_acc = (PROBE_KLOOP == 1) ? kl_save : MISC[16];
#endif
#if PROBE_MASK
    if (bx == 0 && threadIdx.x == 0) { const unsigned long long t0 = __builtin_amdgcn_s_memrealtime(); while (__builtin_amdgcn_s_memrealtime() - t0 < t_acc) __builtin_amdgcn_s_sleep(8); }
#endif
#undef IN
#undef SEAM
}

extern "C" void kernel_launch(void* const* d_in, const int* in_sizes, int n_in, void* d_out, int out_size, void* d_ws, size_t ws_size, hipStream_t stream) {
    static int grid = 0;
    if (grid == 0) {
        if (n_in != 24 || in_sizes[0] != M * DM || out_size != M * DM || ws_size < WS_END) {
            fprintf(stderr, "kernel_launch: unexpected shapes (n_in %d, in0 %d, out %d, ws %zu, need %zu)\n", n_in, n_in > 0 ? in_sizes[0] : -1, out_size, ws_size, (size_t)WS_END); grid = -1; return; }
        int dev = 0, cus = 0, per_cu = 0;
        if (hipGetDevice(&dev) != hipSuccess || hipDeviceGetAttribute(&cus, hipDeviceAttributeMultiprocessorCount, dev) != hipSuccess) { grid = -1; return; }
        if (hipFuncSetAttribute((const void*)layer_fwd, hipFuncAttributeMaxDynamicSharedMemorySize, LDS_BYTES) != hipSuccess) { fprintf(stderr, "kernel_launch: hipFuncSetAttribute failed\n"); grid = -1; return; }
        if (hipOccupancyMaxActiveBlocksPerMultiprocessor(&per_cu, (const void*)layer_fwd, NWAVES * 64, LDS_BYTES) != hipSuccess || per_cu < 1) { fprintf(stderr, "kernel_launch: occupancy query says %d\n", per_cu); per_cu = 1; }
        (void)hipGetLastError();
        grid = cus * per_cu;
    }
    if (grid < 0) return;
    if (hipMemsetAsync((char*)d_ws + WS_BAR, 0, WS_BAR_BYTES, stream) != hipSuccess) { fprintf(stderr, "kernel_launch: memset of the barrier words failed\n"); return; }
    Args a{};
    for (int i = 0; i < 24; ++i) a.in[i] = (const float*)d_in[i];
    a.out = (float*)d_out; a.ws = (unsigned char*)d_ws;
#if ONE_LAUNCH
    a.ph_lo = 0; a.ph_hi = NPHASE;
    void* kargs[] = {&a};
    hipError_t e = hipLaunchCooperativeKernel((const void*)layer_fwd, dim3(grid), dim3(NWAVES * 64), kargs, LDS_BYTES, stream);
    if (e != hipSuccess) fprintf(stderr, "kernel_launch: cooperative launch failed: %s (grid %d)\n", hipGetErrorString(e), grid);
#else
    for (int p = 0; p < NPHASE; ++p) { a.ph_lo = p; a.ph_hi = p + 1;
        hipLaunchKernelGGL(layer_fwd, dim3(grid), dim3(NWAVES * 64), LDS_BYTES, stream, a); }
#endif
}
```

```cpp
#include <hip/hip_runtime.h>
#include <hip/hip_cooperative_groups.h>
#include <cstdio>
#include <cstdint>
namespace cg = cooperative_groups;
#ifndef ONE_LAUNCH
#define ONE_LAUNCH 1
#endif
namespace pg8 {
#define PG8_LAS __attribute__((address_space(3)))
typedef unsigned short bf16_t;
typedef short bf16x8 __attribute__((ext_vector_type(8)));
typedef float f32x4 __attribute__((ext_vector_type(4)));
typedef unsigned u32x4 __attribute__((ext_vector_type(4)));
constexpr int BM = 256, BK = 64, HALF = 128, HTB = HALF * BK * 2  , STAGE_BYTES = 8 * HTB, NXCD = 8, WGM = 8;

__host__ __device__ __forceinline__ int lds_byte(int r, int c) { const int st = (r >> 4) * 2 + (c >> 5), rr = r & 15, cc = c & 31, ob = rr * 64 + cc * 2; return st * 1024 + (ob ^ (((ob >> 9) & 1) << 5)); }
__host__ __device__ __forceinline__ void stage_rc(int b, int& R, int& C) { const int st = b / 1024, sb = b % 1024, swz = sb ^ (((sb >> 9) & 1) << 5); R = (st >> 1) * 16 + swz / 64; C = (st & 1) * 32 + (swz % 64) / 2; }
__host__ __device__ __forceinline__ int perm32(int rho) { const int n = rho >> 4, i = rho & 15; return 8 * (i >> 2) + 4 * n + (i & 3); }

struct Unit { int pm, pn; };
struct Gemm { const bf16_t* A; const bf16_t* Bt; int M, N, K; };

struct StaticOrder {
    int nM, nN, nwg, G, c, wgm;
    __host__ __device__ void init(int M, int N, int G_, int c_, int wgm_ = WGM) { nM = M / BM; nN = N / BM; nwg = nM * nN; G = G_; c = c_; wgm = wgm_; }
    __host__ __device__ bool next(int i, Unit& u) const {
        const long L = (long)i * G + c; if (L >= nwg) return false;
        int wgid = (int)L; { const int q = nwg / NXCD, r = nwg % NXCD, xcd = wgid % NXCD, off = wgid / NXCD; wgid = (xcd < r ? xcd * (q + 1) : r * (q + 1) + (xcd - r) * q) + off; }
        const int nig = wgm * nN, gid = wgid / nig, fm = gid * wgm, gsz = (nM - fm) < wgm ? (nM - fm) : wgm;
        u.pm = fm + ((wgid % nig) % gsz); u.pn = (wgid % nig) / gsz; return true;
    }
    __device__ __forceinline__ void a_ready(const Unit&) const {}
    __device__ __forceinline__ void done(const Unit&) const {}
};
__device__ __forceinline__ unsigned cvt_pk_bf16(float lo, float hi) { unsigned r; asm volatile("v_cvt_pk_bf16_f32 %0, %1, %2" : "=v"(r) : "v"(lo), "v"(hi)); return r; }
constexpr float RMS_EPS = 1e-6f;
__device__ __forceinline__ float fast_sigmoid(float g) { return __builtin_amdgcn_rcpf(1.0f + __builtin_amdgcn_exp2f(-1.4426950408889634f * g)); }
__device__ __forceinline__ f32x4 bf2f_lo(unsigned a, unsigned b) { f32x4 r; r[0] = __uint_as_float(a << 16); r[1] = __uint_as_float(a & 0xffff0000u); r[2] = __uint_as_float(b << 16); r[3] = __uint_as_float(b & 0xffff0000u); return r; }

__device__ __forceinline__ float sum_xor32(float v) { auto r = __builtin_amdgcn_permlane32_swap(__float_as_uint(v), __float_as_uint(v), false, false); return __uint_as_float(r[0]) + __uint_as_float(r[1]); }
__device__ __forceinline__ float sum_xor16(float v) { auto r = __builtin_amdgcn_permlane16_swap(__float_as_uint(v), __float_as_uint(v), false, false); return __uint_as_float(r[0]) + __uint_as_float(r[1]); }
__device__ __forceinline__ float get_xor32(float v, bool upper) { auto r = __builtin_amdgcn_permlane32_swap(__float_as_uint(v), __float_as_uint(v), false, false); return __uint_as_float(upper ? r[0] : r[1]); }
template <bool KB64> struct EpiSwiglu {
    static constexpr bool PERM = true, AFTER_DRAIN = false, HAS_MID = false, KP = false;
    bf16_t* H; int ldh; const float* ss; int mrows;
    __device__ __forceinline__ void operator()(const f32x4 (&acc)[2][2][4][2], const Unit& u, int wr, int wc, int fr, int fq) const {
        const int row0 = u.pm * BM + wr * 64 + fr, col0 = u.pn * HALF + wc * 32 + 8 * fq;
#pragma unroll
        for (int ai = 0; ai < 2; ++ai)
#pragma unroll
            for (int m = 0; m < 4; ++m) { const int row = row0 + ai * HALF + m * 16; const float rs = rsqrtf(ss[row] * (1.0f / 2048.0f) + RMS_EPS);
                float h[8];
#pragma unroll
                for (int n = 0; n < 2; ++n)
#pragma unroll
                    for (int j = 0; j < 4; ++j) { const float g = acc[ai][0][m][n][j] * rs, up = acc[ai][1][m][n][j] * rs; h[n * 4 + j] = g * fast_sigmoid(g) * up; }
                u32x4 w; w.x = cvt_pk_bf16(h[0], h[1]); w.y = cvt_pk_bf16(h[2], h[3]); w.z = cvt_pk_bf16(h[4], h[5]); w.w = cvt_pk_bf16(h[6], h[7]);
                if (KB64) *(u32x4*)(H + (size_t)(col0 >> 6) * ((size_t)mrows * 64) + (size_t)row * 64 + (col0 & 63)) = w;
                else *(u32x4*)(H + (size_t)row * ldh + col0) = w; }
    }
};
template <bool BASE_F32, bool OUT_F32, bool NT_BASE = false> struct EpiResid {
    static constexpr bool PERM = true, AFTER_DRAIN = false, HAS_MID = false, KP = OUT_F32;
    const void* base; float* out; bf16_t* xb; float* ss; float alpha; int ld;
    __device__ __forceinline__ void operator()(const f32x4 (&acc)[2][2][4][2], const Unit& u, int wr, int wc, int fr, int fq) const {
        const int row0 = u.pm * BM + wr * 64 + fr, col0 = u.pn * BM + wc * 32 + 8 * fq;
#pragma unroll
        for (int ai = 0; ai < 2; ++ai) {
            f32x4 bf[4][2][2]; u32x4 bh[4][2];
#pragma unroll
            for (int m = 0; m < 4; ++m)
#pragma unroll
                for (int bj = 0; bj < 2; ++bj) { const size_t p = (size_t)(row0 + ai * HALF + m * 16) * ld + col0 + bj * HALF;
                    if (BASE_F32) { if (NT_BASE) { bf[m][bj][0] = __builtin_nontemporal_load((const f32x4*)((const float*)base + p)); bf[m][bj][1] = __builtin_nontemporal_load((const f32x4*)((const float*)base + p + 4)); }
                                    else { bf[m][bj][0] = *(const f32x4*)((const float*)base + p); bf[m][bj][1] = *(const f32x4*)((const float*)base + p + 4); } }
                    else { if (NT_BASE) bh[m][bj] = __builtin_nontemporal_load((const u32x4*)((const bf16_t*)base + p)); else bh[m][bj] = *(const u32x4*)((const bf16_t*)base + p); } }
            asm volatile("" ::: "memory");
#pragma unroll
            for (int m = 0; m < 4; ++m) { const int row = row0 + ai * HALF + m * 16; float s = 0.f;
#pragma unroll
                for (int bj = 0; bj < 2; ++bj) { const size_t p = (size_t)row * ld + col0 + bj * HALF;
                    f32x4 b0, b1;
                    if (BASE_F32) { b0 = bf[m][bj][0]; b1 = bf[m][bj][1]; }
                    else { b0 = bf2f_lo(bh[m][bj].x, bh[m][bj].y); b1 = bf2f_lo(bh[m][bj].z, bh[m][bj].w); }
                    const f32x4 v0 = b0 + acc[ai][bj][m][0] * alpha, v1 = b1 + acc[ai][bj][m][1] * alpha;
                    if (OUT_F32) { __builtin_nontemporal_store(v0, (f32x4*)(out + p)); __builtin_nontemporal_store(v1, (f32x4*)(out + p + 4)); }
                    if (xb) { u32x4 w; w.x = cvt_pk_bf16(v0[0], v0[1]); w.y = cvt_pk_bf16(v0[2], v0[3]); w.z = cvt_pk_bf16(v1[0], v1[1]); w.w = cvt_pk_bf16(v1[2], v1[3]); *(u32x4*)(xb + p) = w; }
                    s += (v0[0] * v0[0] + v0[1] * v0[1]) + (v0[2] * v0[2] + v0[3] * v0[3]) + (v1[0] * v1[0] + v1[1] * v1[1]) + (v1[2] * v1[2] + v1[3] * v1[3]); }
                if (ss) { s = sum_xor16(s); s = sum_xor32(s); if (fq == 0) atomicAdd(ss + row, s); } }
            asm volatile("" ::: "memory");
        }
    }
};
struct EpiProj {
    static constexpr bool PERM = true, AFTER_DRAIN = false, HAS_MID = false, KP = false;
    bf16_t* O0; int ld0; bf16_t* O1; int ld1; int split_pn; const float* ss;
    const float* gdq; const float* gdk; const float* gfq; const float* gfk; const float* cosT; const float* sinT; PG8_LAS float* P;
    __device__ __forceinline__ void operator()(const f32x4 (&acc_)[2][2][4][2], const Unit& u, int wr, int wc, int fr, int fq) const {
        f32x4 (&acc)[2][2][4][2] = const_cast<f32x4 (&)[2][2][4][2]>(acc_);
        const int pn = u.pn;
        const int kind = pn < 6 ? 0 : (pn < 12 ? 1 : ((pn >= 18 && pn < 22) ? 2 : ((pn >= 22 && pn < 26) ? 3 : -1)));
        const int rl0 = wr * 64 + fr, row0 = pn * 0 + u.pm * BM + rl0; const bool first = pn < split_pn;
        bf16_t* O = first ? O0 : O1; const int ld = first ? ld0 : ld1; const int col0 = (first ? pn : pn - split_pn) * BM + wc * 32 + 8 * fq;
#pragma unroll
        for (int ai = 0; ai < 2; ++ai)
#pragma unroll
            for (int m = 0; m < 4; ++m) { const int rl = rl0 + ai * HALF + m * 16; const float rs = rsqrtf(ss[u.pm * BM + rl] * (1.0f / 2048.0f) + RMS_EPS);
#pragma unroll
                for (int bj = 0; bj < 2; ++bj) { acc[ai][bj][m][0] = acc[ai][bj][m][0] * rs; acc[ai][bj][m][1] = acc[ai][bj][m][1] * rs;
                    if (kind >= 0) { const f32x4 a = acc[ai][bj][m][0], b = acc[ai][bj][m][1];
                        float s = (a[0] * a[0] + a[1] * a[1]) + (a[2] * a[2] + a[3] * a[3]) + (b[0] * b[0] + b[1] * b[1]) + (b[2] * b[2] + b[3] * b[3]);
                        s = sum_xor16(s); s = sum_xor32(s);
                        if (fq == 0) P[(rl * 2 + bj) * 4 + wc] = s; } } }
        f32x4 g0 = {1.f, 1.f, 1.f, 1.f}, g1 = g0;
        if (kind >= 0) {
            asm volatile("s_waitcnt lgkmcnt(0)" ::: "memory"); __builtin_amdgcn_s_barrier(); asm volatile("" ::: "memory");
            const float* gp = (kind == 0 ? gdq : (kind == 1 ? gdk : (kind == 2 ? gfq : gfk))) + wc * 32 + 8 * fq;
            g0 = *(const f32x4*)gp; g1 = *(const f32x4*)(gp + 4);
        }
        const bool rope = kind >= 0 && wc == 0; const float sgn = fq < 2 ? -1.0f : 1.0f;
#pragma unroll
        for (int ai = 0; ai < 2; ++ai)
#pragma unroll
            for (int m = 0; m < 4; ++m) { const int rl = rl0 + ai * HALF + m * 16, row = u.pm * BM + rl;
                f32x4 c0, c1, s0, s1;
                if (rope) { const float* cp = cosT + (size_t)row * 16 + 8 * (fq & 1); const float* sp = sinT + (size_t)row * 16 + 8 * (fq & 1);
                    c0 = *(const f32x4*)cp; c1 = *(const f32x4*)(cp + 4); s0 = *(const f32x4*)sp; s1 = *(const f32x4*)(sp + 4); }
#pragma unroll
                for (int bj = 0; bj < 2; ++bj) { f32x4 v0 = acc[ai][bj][m][0], v1 = acc[ai][bj][m][1];
                    if (kind >= 0) { const f32x4 p4 = *(const PG8_LAS f32x4*)(P + (rl * 2 + bj) * 4);
                        const float rh = rsqrtf(((p4[0] + p4[1]) + (p4[2] + p4[3])) * (1.0f / 128.0f) + RMS_EPS);
                        v0 = v0 * rh * g0; v1 = v1 * rh * g1;
                        if (rope) {
#pragma unroll
                            for (int j = 0; j < 4; ++j) { const float p0 = get_xor32(v0[j], fq >= 2), p1 = get_xor32(v1[j], fq >= 2);
                                v0[j] = v0[j] * c0[j] + sgn * p0 * s0[j]; v1[j] = v1[j] * c1[j] + sgn * p1 * s1[j]; } } }
                    u32x4 w; w.x = cvt_pk_bf16(v0[0], v0[1]); w.y = cvt_pk_bf16(v0[2], v0[3]); w.z = cvt_pk_bf16(v1[0], v1[1]); w.w = cvt_pk_bf16(v1[2], v1[3]);
                    *(u32x4*)(O + (size_t)row * ld + col0 + bj * HALF) = w; } }
    }
};
struct EpiGateMerge {
    static constexpr bool PERM = true, AFTER_DRAIN = false, HAS_MID = true, KP = false;
    const bf16_t* gate; int ldg; bf16_t* Y; int ldy; int mid_t;
    __device__ __forceinline__ void mid(f32x4 (&acc)[2][2][4][2], const Unit& u, int wr, int wc, int fr, int fq) const {
        int row0 = u.pm * BM + wr * 64 + fr, col0 = u.pn * BM + wc * 32 + 8 * fq;
        asm volatile("" : "+v"(row0), "+v"(col0));
#pragma unroll
        for (int ai = 0; ai < 2; ++ai)
#pragma unroll
            for (int m = 0; m < 4; ++m)
#pragma unroll
                for (int bj = 0; bj < 2; ++bj) { const bf16_t* gp = gate + (size_t)(row0 + ai * HALF + m * 16) * ldg + col0 + bj * HALF;
                    const u32x4 ga = *(const u32x4*)gp, gb = *(const u32x4*)(gp + 2048);
                    const f32x4 a0 = bf2f_lo(ga.x, ga.y), a1 = bf2f_lo(ga.z, ga.w), b0 = bf2f_lo(gb.x, gb.y), b1 = bf2f_lo(gb.z, gb.w);
#pragma unroll
                    for (int j = 0; j < 4; ++j) {
                        acc[ai][bj][m][0][j] *= (1.0f + __builtin_amdgcn_exp2f(-1.4426950408889634f * b0[j])) * __builtin_amdgcn_rcpf(1.0f + __builtin_amdgcn_exp2f(-1.4426950408889634f * a0[j]));
                        acc[ai][bj][m][1][j] *= (1.0f + __builtin_amdgcn_exp2f(-1.4426950408889634f * b1[j])) * __builtin_amdgcn_rcpf(1.0f + __builtin_amdgcn_exp2f(-1.4426950408889634f * a1[j])); }
                    asm volatile("" ::: "memory"); }
    }
    __device__ __forceinline__ void operator()(const f32x4 (&acc)[2][2][4][2], const Unit& u, int wr, int wc, int fr, int fq) const {
        const int row0 = u.pm * BM + wr * 64 + fr, col0 = u.pn * BM + wc * 32 + 8 * fq;
#pragma unroll
        for (int ai = 0; ai < 2; ++ai)
#pragma unroll
            for (int m = 0; m < 4; ++m) { const int row = row0 + ai * HALF + m * 16;
#pragma unroll
                for (int bj = 0; bj < 2; ++bj) { const int col = col0 + bj * HALF;
                    const u32x4 gw = *(const u32x4*)(gate + (size_t)row * ldg + 2048 + col);
                    const f32x4 g0 = bf2f_lo(gw.x, gw.y), g1 = bf2f_lo(gw.z, gw.w);
                    f32x4 v0, v1;
#pragma unroll
                    for (int j = 0; j < 4; ++j) { v0[j] = fast_sigmoid(g0[j]) * acc[ai][bj][m][0][j]; v1[j] = fast_sigmoid(g1[j]) * acc[ai][bj][m][1][j]; }
                    u32x4 w; w.x = cvt_pk_bf16(v0[0], v0[1]); w.y = cvt_pk_bf16(v0[2], v0[3]); w.z = cvt_pk_bf16(v1[0], v1[1]); w.w = cvt_pk_bf16(v1[2], v1[3]);
                    *(u32x4*)(Y + (size_t)row * ldy + col) = w; } }
    }
};

template <class Epi, class Sched, bool ALIGN_EPI = false, bool SP2 = false, bool KB64 = false>
__device__ __forceinline__ void gemm_phase(PG8_LAS unsigned char* lds, const Gemm g, const Sched& S, const Epi& E) {
    int tid_ = threadIdx.x; asm volatile("" : "+v"(tid_));
    const int tid = tid_, wid = __builtin_amdgcn_readfirstlane(tid >> 6), lane = tid & 63, wr = wid >> 2, wc = wid & 3, fr = lane & 15, fq = lane >> 4;
    const int K = g.K, nt = K / BK;
    unsigned voffA[2], voffB[2];
#pragma unroll
    for (int i = 0; i < 2; ++i) { int R, C; stage_rc(tid * 16 + i * 8192, R, C); const int Rb = Epi::PERM ? ((R & ~31) + perm32(R & 31)) : R;
        voffA[i] = (unsigned)(R * (KB64 ? 64 : K) + C) * 2u; voffB[i] = (unsigned)(Rb * (KB64 ? 64 : K) + C) * 2u; }
    const size_t kstepA = KB64 ? (size_t)g.M * (BK * 2) : (size_t)(BK * 2), kstepB = KB64 ? (size_t)g.N * (BK * 2) : (size_t)(BK * 2);
    const size_t hstep = KB64 ? (size_t)HALF * BK * 2 : (size_t)HALF * K * 2;
    const size_t tstep = 2 * hstep;
    const unsigned ldsw = (unsigned)wid * 1024u;
    const int aoff = lds_byte(wr * 64 + fr, fq * 8), boff = lds_byte(wc * 32 + fr, fq * 8);
#define PG8_SA(b, h) (((b) * 2 + (h)) * HTB)
#define PG8_SB(b, h) ((4 + (b) * 2 + (h)) * HTB)
#define PG8_STAGE(bufoff, gbase, voff) do { _Pragma("unroll") for (int _i = 0; _i < 2; ++_i) \
        __builtin_amdgcn_global_load_lds((const unsigned*)((const char*)(gbase) + (voff)[_i]), (PG8_LAS unsigned*)(lds + (bufoff) + ldsw + _i * 8192), 16, 0, 0); } while (0)
#define PG8_LDA(dst, b, h) do { _Pragma("unroll") for (int m = 0; m < 4; ++m) _Pragma("unroll") for (int k = 0; k < 2; ++k) dst[m][k] = *(const PG8_LAS bf16x8*)(lds + PG8_SA(b, h) + aoff + m * 2048 + k * 1024); } while (0)
#define PG8_LDB(dst, b, h) do { _Pragma("unroll") for (int n = 0; n < 2; ++n) _Pragma("unroll") for (int k = 0; k < 2; ++k) dst[n][k] = *(const PG8_LAS bf16x8*)(lds + PG8_SB(b, h) + boff + n * 2048 + k * 1024); } while (0)
#define PG8_MMA(ai, bj, At, Bt) do { __builtin_amdgcn_s_setprio(1); _Pragma("unroll") for (int m = 0; m < 4; ++m) _Pragma("unroll") for (int n = 0; n < 2; ++n) _Pragma("unroll") for (int k = 0; k < 2; ++k) \
        acc[ai][bj][m][n] = __builtin_amdgcn_mfma_f32_16x16x32_bf16(Bt[n][k], At[m][k], acc[ai][bj][m][n], 0, 0, 0); __builtin_amdgcn_s_setprio(0); } while (0)
#define PG8_WAIT_V(n) asm volatile("s_waitcnt vmcnt(" #n ")" ::: "memory")
#define PG8_WAIT_L(n) asm volatile("s_waitcnt lgkmcnt(" #n ")" ::: "memory")
#define PG8_BAR __builtin_amdgcn_s_barrier()
#define PG8_SCHED __builtin_amdgcn_sched_barrier(0)
    Unit cur, nxt; int ui = 0;
    if (!S.next(0, cur)) return;
    f32x4 acc[2][2][4][2];
#pragma unroll
    for (int a = 0; a < 2; ++a)
#pragma unroll
        for (int b = 0; b < 2; ++b)
#pragma unroll
            for (int m = 0; m < 4; ++m)
#pragma unroll
                for (int n = 0; n < 2; ++n) acc[a][b][m][n] = (f32x4){0.f, 0.f, 0.f, 0.f};
    bf16x8 At[4][2], B0[2][2], B1[2][2];
    const char* cA = (const char*)g.A + (size_t)cur.pm * tstep; const char* cB = (const char*)g.Bt + (size_t)cur.pn * tstep;
    S.a_ready(cur);
    if constexpr (SP2) {
        PG8_STAGE(PG8_SB(0, 0), cB, voffB); PG8_STAGE(PG8_SB(0, 1), cB + hstep, voffB); PG8_STAGE(PG8_SA(0, 0), cA, voffA); PG8_STAGE(PG8_SA(0, 1), cA + hstep, voffA);
        if (wr == 1) PG8_BAR;
        PG8_WAIT_V(2); PG8_BAR;
        PG8_STAGE(PG8_SB(1, 0), cB + kstepB, voffB); PG8_STAGE(PG8_SA(1, 0), cA + kstepA, voffA); PG8_STAGE(PG8_SB(1, 1), cB + hstep + kstepB, voffB);
        PG8_WAIT_V(6); PG8_BAR;
    } else {
        PG8_STAGE(PG8_SB(0, 0), cB, voffB); PG8_STAGE(PG8_SA(0, 0), cA, voffA); PG8_STAGE(PG8_SB(0, 1), cB + hstep, voffB); PG8_STAGE(PG8_SA(0, 1), cA + hstep, voffA);
        if (wr == 1) PG8_BAR;
        PG8_WAIT_V(4); PG8_BAR;
        PG8_STAGE(PG8_SB(1, 0), cB + kstepB, voffB); PG8_STAGE(PG8_SA(1, 0), cA + kstepA, voffA); PG8_STAGE(PG8_SB(1, 1), cB + hstep + kstepB, voffB);
        PG8_WAIT_V(6); PG8_BAR;
    }
    for (;;) {
        const bool has_next = S.next(ui + 1, nxt);
        const char* nA = has_next ? (const char*)g.A + (size_t)nxt.pm * tstep : cA; const char* nB = has_next ? (const char*)g.Bt + (size_t)nxt.pn * tstep : cB;
#ifdef PROBE_KLOOP
#ifdef PROBE_KCYC
        const unsigned long long pk_t0 = __builtin_amdgcn_s_memtime();
#else
        const unsigned long long pk_t0 = __builtin_amdgcn_s_memrealtime();
#endif
#endif
        for (int t = 0; t < nt; t += 2) {
            const bool last = (t == nt - 2);
            const char* a1 = cA + (size_t)(t + 1) * kstepA;
            const char* a2 = last ? nA : cA + (size_t)(t + 2) * kstepA; const char* b2 = last ? nB : cB + (size_t)(t + 2) * kstepB;
            const char* a3 = a2 + kstepA; const char* b3 = b2 + kstepB;
#ifdef KPAUSE
            if constexpr (Epi::KP) { if (t == 32 || t == 64) { __builtin_amdgcn_s_sleep(KPAUSE); } }
#endif
            if constexpr (Epi::HAS_MID) { if (t == E.mid_t) E.mid(acc, cur, wr, wc, fr, fq); }
            if (last && has_next) S.a_ready(nxt);
            if constexpr (SP2) {
            PG8_LDB(B0, 0, 0); PG8_LDB(B1, 0, 1); PG8_SCHED; PG8_LDA(At, 0, 0); PG8_STAGE(PG8_SA(1, 1), a1 + hstep, voffA);
            PG8_WAIT_V(8); PG8_WAIT_L(0); PG8_BAR; PG8_MMA(0, 0, At, B0); PG8_MMA(0, 1, At, B1); PG8_BAR; PG8_SCHED;
            PG8_LDA(At, 0, 1); PG8_STAGE(PG8_SB(0, 0), b2, voffB); PG8_STAGE(PG8_SB(0, 1), b2 + hstep, voffB); PG8_STAGE(PG8_SA(0, 0), a2, voffA);
            PG8_WAIT_V(8); PG8_WAIT_L(0); PG8_BAR; PG8_MMA(1, 0, At, B0); PG8_MMA(1, 1, At, B1); PG8_BAR; PG8_SCHED;
            PG8_LDB(B0, 1, 0); PG8_LDB(B1, 1, 1); PG8_SCHED; PG8_LDA(At, 1, 0); PG8_STAGE(PG8_SA(0, 1), a2 + hstep, voffA);
            PG8_WAIT_V(8); PG8_WAIT_L(0); PG8_BAR; PG8_MMA(0, 0, At, B0); PG8_MMA(0, 1, At, B1); PG8_BAR; PG8_SCHED;
            PG8_LDA(At, 1, 1); PG8_STAGE(PG8_SB(1, 0), b3, voffB); PG8_STAGE(PG8_SB(1, 1), b3 + hstep, voffB); PG8_STAGE(PG8_SA(1, 0), a3, voffA);
            PG8_WAIT_V(8); PG8_WAIT_L(0); PG8_BAR; PG8_MMA(1, 0, At, B0); PG8_MMA(1, 1, At, B1); PG8_BAR; PG8_SCHED;
            } else {
            PG8_LDB(B0, 0, 0); PG8_SCHED; PG8_LDA(At, 0, 0); PG8_STAGE(PG8_SA(1, 1), a1 + hstep, voffA);
            PG8_WAIT_L(8); PG8_BAR; PG8_WAIT_L(0); PG8_MMA(0, 0, At, B0); PG8_BAR; PG8_SCHED;
            PG8_LDB(B1, 0, 1); PG8_STAGE(PG8_SB(0, 0), b2, voffB);
            PG8_BAR; PG8_WAIT_L(0); PG8_MMA(0, 1, At, B1); PG8_BAR;
            PG8_LDA(At, 0, 1); PG8_STAGE(PG8_SA(0, 0), a2, voffA);
            PG8_BAR; PG8_WAIT_L(0); PG8_MMA(1, 0, At, B0); PG8_BAR; PG8_SCHED;
            PG8_STAGE(PG8_SB(0, 1), b2 + hstep, voffB);
            PG8_WAIT_V(6); PG8_BAR; PG8_MMA(1, 1, At, B1); PG8_BAR;
            PG8_LDB(B0, 1, 0); PG8_SCHED; PG8_LDA(At, 1, 0); PG8_STAGE(PG8_SA(0, 1), a2 + hstep, voffA);
            PG8_WAIT_L(8); PG8_BAR; PG8_WAIT_L(0); PG8_MMA(0, 0, At, B0); PG8_BAR; PG8_SCHED;
            PG8_LDB(B1, 1, 1); PG8_STAGE(PG8_SB(1, 0), b3, voffB);
            PG8_BAR; PG8_WAIT_L(0); PG8_MMA(0, 1, At, B1); PG8_BAR;
            PG8_LDA(At, 1, 1); PG8_STAGE(PG8_SA(1, 0), a3, voffA);
            PG8_BAR; PG8_WAIT_L(0); PG8_MMA(1, 0, At, B0); PG8_BAR; PG8_SCHED;
            PG8_STAGE(PG8_SB(1, 1), b3 + hstep, voffB);
            PG8_WAIT_V(6); PG8_BAR; PG8_MMA(1, 1, At, B1); PG8_BAR;
            }
        }
#ifdef PROBE_KLOOP
#ifdef PROBE_KCYC
        if (tid == 0) *(PG8_LAS unsigned*)(lds + 139264 + 64) += (unsigned)((__builtin_amdgcn_s_memtime() - pk_t0) / 20);
#else
        if (tid == 0) *(PG8_LAS unsigned*)(lds + 139264 + 64) += (unsigned)(__builtin_amdgcn_s_memrealtime() - pk_t0);
#endif
#endif
        if constexpr (ALIGN_EPI) { if (wr == 0) PG8_BAR; }
        if constexpr (!Epi::AFTER_DRAIN) { E(acc, cur, wr, wc, fr, fq); S.done(cur); }
        if (!has_next) break;
#pragma unroll
        for (int a = 0; a < 2; ++a)
#pragma unroll
            for (int b = 0; b < 2; ++b)
#pragma unroll
                for (int m = 0; m < 4; ++m)
#pragma unroll
                    for (int n = 0; n < 2; ++n) acc[a][b][m][n] = (f32x4){0.f, 0.f, 0.f, 0.f};
        cur = nxt; cA = nA; cB = nB; ++ui;
        if constexpr (ALIGN_EPI) { if (wr == 1) PG8_BAR; }
    }
    PG8_WAIT_V(0);
    if constexpr (!ALIGN_EPI) { if (wr == 0) PG8_BAR; }
    PG8_BAR;
    if constexpr (Epi::AFTER_DRAIN) { E.fused(acc, cur, wr, wc, fr, fq, lds, wid, lane); S.done(cur); }
#undef PG8_SA
#undef PG8_SB
#undef PG8_STAGE
#undef PG8_LDA
#undef PG8_LDB
#undef PG8_MMA
#undef PG8_WAIT_V
#undef PG8_WAIT_L
#undef PG8_BAR
#undef PG8_SCHED
}
}
namespace att {
typedef unsigned short bf16_t;
typedef short bf16x8 __attribute__((ext_vector_type(8)));
typedef short s16x4 __attribute__((ext_vector_type(4)));
typedef float f32x16 __attribute__((ext_vector_type(16)));
typedef float f32x4 __attribute__((ext_vector_type(4)));
typedef unsigned u32x4 __attribute__((ext_vector_type(4)));
constexpr int D = 128;
constexpr float SCALE = 0.08838834764831845f;
constexpr float THR = 8.f;
constexpr int NW = 8, QBLK = 32, KVBLK = 64, QB = NW * QBLK;
constexpr int SHM_V = KVBLK * D * 2, SHM_K = KVBLK * D * 2;
constexpr int LDS_BYTES = 2 * SHM_V + 2 * SHM_K + NW * 64 * 4;

#define KSWZ(row, colB) ((row) * 256 + ((colB) ^ (((row) & 7) << 4)))
#define SBAR() __builtin_amdgcn_sched_barrier(0)
__device__ __forceinline__ int v_st(int k, int c) { const int kk = (k & ~0xC) | ((k & 4) << 1) | ((k & 8) >> 1); return ((kk >> 3) * 4 + (c >> 5)) * 512 + ((kk & 7) * 32 + (c & 31)) * 2; }
__device__ __forceinline__ int v_rd_base(int lane) { return ((lane & 3) << 3) | (((lane >> 2) & 3) << 6) | (((lane >> 4) & 1) << 5) | (((lane >> 5) & 1) << 8); }
constexpr int v_rd_off(int d0, int ks, int half) { return d0 * 512 + ks * 4096 + half * 2048; }
__device__ __forceinline__ int crow(int r, int hi) { return (r & 3) + 8 * (r >> 2) + 4 * hi; }
__device__ __forceinline__ unsigned cvtpk(float lo, float hi) { unsigned r; asm volatile("v_cvt_pk_bf16_f32 %0, %1, %2" : "=v"(r) : "v"(lo), "v"(hi)); return r; }
__device__ __forceinline__ bf16x8 ld8(const bf16_t* p) { return *reinterpret_cast<const bf16x8*>(p); }
__device__ __forceinline__ void mask_tile(f32x16& p0, f32x16& p1, int dq, unsigned W) {
    const float NEG = -__builtin_inff();
#pragma unroll
    for (int r = 0; r < 16; ++r) {
        const int c = (r & 3) + 8 * (r >> 2);
        if ((unsigned)(dq - c) >= W) p0[r] = NEG;
        if ((unsigned)(dq - c - 32) >= W) p1[r] = NEG;
    }
}
__device__ __forceinline__ void partialSM(f32x16& p0, f32x16& p1, float& m_reg, float& mn, float& alpha) {
    float pmax = p0[0]; for (int r = 1; r < 16; ++r) pmax = fmaxf(pmax, p0[r]); for (int r = 0; r < 16; ++r) pmax = fmaxf(pmax, p1[r]);
    { auto rr = __builtin_amdgcn_permlane32_swap(__float_as_uint(pmax), __float_as_uint(pmax), false, false);
      pmax = fmaxf(__uint_as_float(rr[0]), __uint_as_float(rr[1])); }
    constexpr float C2 = 1.4426950408889634f * SCALE;
    if (__builtin_expect(__all((pmax - m_reg) * SCALE <= THR), 1)) { mn = m_reg; alpha = 1.f; }
    else { mn = fmaxf(m_reg, pmax); alpha = __builtin_amdgcn_exp2f((m_reg - mn) * C2); m_reg = mn; }
    const float mnL = -mn * C2;
    for (int r = 0; r < 16; ++r) p0[r] = fmaf(p0[r], C2, mnL); for (int r = 0; r < 16; ++r) p1[r] = fmaf(p1[r], C2, mnL);
    for (int r = 0; r < 16; ++r) p0[r] = __builtin_amdgcn_exp2f(p0[r]);
}
__device__ __forceinline__ void finishSM(f32x16& p0, f32x16& p1, float alpha, float& l_reg, bf16x8& pa0, bf16x8& pa1, bf16x8& pa2, bf16x8& pa3) {
    for (int r = 0; r < 16; ++r) p1[r] = __builtin_amdgcn_exp2f(p1[r]);
    float ps = 0; for (int r = 0; r < 16; ++r) ps += p0[r]; for (int r = 0; r < 16; ++r) ps += p1[r];
    { auto rr = __builtin_amdgcn_permlane32_swap(__float_as_uint(ps), __float_as_uint(ps), false, false);
      ps = __uint_as_float(rr[0]) + __uint_as_float(rr[1]); }
    l_reg = l_reg * alpha + ps;
#define PK4(P, B_, OUT) do { unsigned a0 = cvtpk(P[B_+0], P[B_+1]), a1 = cvtpk(P[B_+2], P[B_+3]);                          \
        unsigned b0 = cvtpk(P[B_+4], P[B_+5]), b1 = cvtpk(P[B_+6], P[B_+7]);                                             \
        auto r0 = __builtin_amdgcn_permlane32_swap(a0, b0, false, false); auto r1 = __builtin_amdgcn_permlane32_swap(a1, b1, false, false); \
        u32x4 w = {r0[0], r1[0], r0[1], r1[1]}; OUT = *reinterpret_cast<bf16x8*>(&w); } while (0)
    PK4(p0, 0, pa0); PK4(p0, 8, pa1); PK4(p1, 0, pa2); PK4(p1, 8, pa3);
#undef PK4
}
template <int KB>
__device__ __forceinline__ void qkt(f32x16& p0, f32x16& p1, const char* K_lds, int r32, int hi, const bf16x8* qr) {
    p0 = f32x16{}; p1 = f32x16{};
    const char* kb[4];
#pragma unroll
    for (int dd = 0; dd < 4; ++dd) kb[dd] = K_lds + KB * SHM_K + KSWZ(r32, (dd * 16 + hi * 8) * 2);
#pragma unroll
    for (int d0 = 0; d0 < 8; ++d0) { const char* a = kb[d0 & 3] + (d0 >> 2) * 128;
        bf16x8 b0 = *reinterpret_cast<const bf16x8*>(a);
        bf16x8 b1 = *reinterpret_cast<const bf16x8*>(a + 32 * 256);
        p0 = __builtin_amdgcn_mfma_f32_32x32x16_bf16(b0, qr[d0], p0, 0, 0, 0);
        p1 = __builtin_amdgcn_mfma_f32_32x32x16_bf16(b1, qr[d0], p1, 0, 0, 0); }
}
template <int VB, int VSTRIDE = SHM_V>
__device__ __forceinline__ void pv_tile(f32x16* o, int vb0, bf16x8 pa0, bf16x8 pa1, bf16x8 pa2, bf16x8 pa3) {
#define TRRD(dst, off) asm volatile("ds_read_b64_tr_b16 %0, %1 offset:%2" : "=&v"(dst) : "v"(vb0), "i"(off) : "memory")
#define PV_D0(d0) do { s16x4 l0, l1, l2, l3, h0, h1, h2, h3; constexpr int b_ = VB * VSTRIDE + v_rd_off(d0, 0, 0);   \
        TRRD(l0, b_); TRRD(h0, b_ + 2048); TRRD(l1, b_ + 4096); TRRD(h1, b_ + 6144); TRRD(l2, b_ + 8192); TRRD(h2, b_ + 10240); TRRD(l3, b_ + 12288); TRRD(h3, b_ + 14336); \
        asm volatile("s_waitcnt lgkmcnt(0)" ::: "memory"); SBAR();   \
        o[d0] = __builtin_amdgcn_mfma_f32_32x32x16_bf16(pa0, (bf16x8){l0[0], l0[1], l0[2], l0[3], h0[0], h0[1], h0[2], h0[3]}, o[d0], 0, 0, 0);   \
        o[d0] = __builtin_amdgcn_mfma_f32_32x32x16_bf16(pa1, (bf16x8){l1[0], l1[1], l1[2], l1[3], h1[0], h1[1], h1[2], h1[3]}, o[d0], 0, 0, 0);   \
        o[d0] = __builtin_amdgcn_mfma_f32_32x32x16_bf16(pa2, (bf16x8){l2[0], l2[1], l2[2], l2[3], h2[0], h2[1], h2[2], h2[3]}, o[d0], 0, 0, 0);   \
        o[d0] = __builtin_amdgcn_mfma_f32_32x32x16_bf16(pa3, (bf16x8){l3[0], l3[1], l3[2], l3[3], h3[0], h3[1], h3[2], h3[3]}, o[d0], 0, 0, 0); } while (0)
    PV_D0(0); PV_D0(1); PV_D0(2); PV_D0(3);
#undef PV_D0
#undef TRRD
}


template <int B>
__device__ __forceinline__ void pv_wide(f32x16* o, int vb0, bf16x8 pa0, bf16x8 pa1, bf16x8 pa2, bf16x8 pa3) {
#define TRRD(dst, off) asm volatile("ds_read_b64_tr_b16 %0, %1 offset:%2" : "=&v"(dst) : "v"(vb0), "i"(off) : "memory")
#define RD8(S, g) do { constexpr int b_ = B * 32768 + ((g) >> 2) * 16384 + v_rd_off((g) & 3, 0, 0); \
        TRRD(S##l0, b_); TRRD(S##h0, b_ + 2048); TRRD(S##l1, b_ + 4096); TRRD(S##h1, b_ + 6144); TRRD(S##l2, b_ + 8192); TRRD(S##h2, b_ + 10240); TRRD(S##l3, b_ + 12288); TRRD(S##h3, b_ + 14336); } while (0)
#define MM4(S, g) do { \
        o[g] = __builtin_amdgcn_mfma_f32_32x32x16_bf16(pa0, (bf16x8){S##l0[0], S##l0[1], S##l0[2], S##l0[3], S##h0[0], S##h0[1], S##h0[2], S##h0[3]}, o[g], 0, 0, 0); \
        o[g] = __builtin_amdgcn_mfma_f32_32x32x16_bf16(pa1, (bf16x8){S##l1[0], S##l1[1], S##l1[2], S##l1[3], S##h1[0], S##h1[1], S##h1[2], S##h1[3]}, o[g], 0, 0, 0); \
        o[g] = __builtin_amdgcn_mfma_f32_32x32x16_bf16(pa2, (bf16x8){S##l2[0], S##l2[1], S##l2[2], S##l2[3], S##h2[0], S##h2[1], S##h2[2], S##h2[3]}, o[g], 0, 0, 0); \
        o[g] = __builtin_amdgcn_mfma_f32_32x32x16_bf16(pa3, (bf16x8){S##l3[0], S##l3[1], S##l3[2], S##l3[3], S##h3[0], S##h3[1], S##h3[2], S##h3[3]}, o[g], 0, 0, 0); } while (0)
#define LW8() do { asm volatile("s_waitcnt lgkmcnt(8)" ::: "memory"); SBAR(); } while (0)
    s16x4 Al0, Al1, Al2, Al3, Ah0, Ah1, Ah2, Ah3, Bl0, Bl1, Bl2, Bl3, Bh0, Bh1, Bh2, Bh3;
    RD8(A, 0);
    RD8(B, 1); LW8(); MM4(A, 0); SBAR();
    RD8(A, 2); LW8(); MM4(B, 1); SBAR();
    RD8(B, 3); LW8(); MM4(A, 2); SBAR();
    RD8(A, 4); LW8(); MM4(B, 3); SBAR();
    RD8(B, 5); LW8(); MM4(A, 4); SBAR();
    RD8(A, 6); LW8(); MM4(B, 5); SBAR();
    RD8(B, 7); LW8(); MM4(A, 6); SBAR();
    asm volatile("s_waitcnt lgkmcnt(0)" ::: "memory"); SBAR(); MM4(B, 7);
#undef LW8
#undef MM4
#undef RD8
#undef TRRD
}

struct BlockRef { const bf16_t* Q; const bf16_t* K; const bf16_t* V; bf16_t* O; float* LSE; int rs, os, ls, P0, W, skv; };
struct Seam { bf16x8 qr[8]; bf16x8 st_v0, st_v1, st_k0, st_k1; };
__device__ __forceinline__ int swa_jlo(int P0, int W) { const int lowk = P0 - W + 1; return lowk > 0 ? lowk / KVBLK : 0; }
#define VMW() asm volatile("s_waitcnt vmcnt(0)" ::: "memory")
#define VMWN(n) asm volatile("s_waitcnt vmcnt(%0)" :: "i"(n) : "memory")
#define SLOAD_H(Kp, Vp, RS, k0) do { const bf16_t* kq_ = (Kp) + (size_t)(k0) * (RS); const bf16_t* vq_ = (Vp) + (size_t)(k0) * (RS); const int o0_ = sr * (RS) + sc, o1_ = (32 + sr) * (RS) + sc; \
                         S.st_v0 = ld8(vq_ + o0_); S.st_v1 = ld8(vq_ + o1_); S.st_k0 = ld8(kq_ + o0_); S.st_k1 = ld8(kq_ + o1_); } while (0)
#define SWRITE_HK(bf) do { *(bf16x8*)(K_lds + (bf) * SHM_K + kws) = S.st_k0; *(bf16x8*)(K_lds + (bf) * SHM_K + kws + 32 * 256) = S.st_k1; } while (0)
#define SWRITE_HV(bf) do { *(bf16x8*)(V_lds + (bf) * SHM_V + vst0) = S.st_v0; *(bf16x8*)(V_lds + (bf) * SHM_V + vst1) = S.st_v1; } while (0)
#define SWRITE_H(bf) do { SWRITE_HV(bf); SWRITE_HK(bf); } while (0)
__device__ __forceinline__ void attn_prime(const BlockRef& cur, char* lds, Seam& S) {
    int tid_ = threadIdx.x; asm volatile("" : "+v"(tid_));
    const int tid = tid_, wid = __builtin_amdgcn_readfirstlane(tid >> 6), lane = tid & 63, r32 = lane & 31, hi = lane >> 5;
    const int sr = tid >> 4, sc = (tid & 15) * 8, kws = KSWZ(sr, sc * 2); char* K_lds = lds + 2 * SHM_V;
    const int kb0 = swa_jlo(cur.P0, cur.W) * KVBLK;
    for (int d0 = 0; d0 < 8; ++d0) S.qr[d0] = ld8(cur.Q + (size_t)(wid * QBLK + r32) * cur.rs + d0 * 16 + hi * 8);
    SLOAD_H(cur.K, cur.V, cur.rs, kb0); VMW(); SWRITE_HK(0);
    __syncthreads();
}
__device__ __forceinline__ void attn_block(const BlockRef& cur, const BlockRef& nxt, char* lds, Seam& S) {
    int tid_ = threadIdx.x; asm volatile("" : "+v"(tid_));
    const int tid = tid_, wid = __builtin_amdgcn_readfirstlane(tid >> 6), lane = tid & 63, r32 = lane & 31, hi = lane >> 5;
    const int W = cur.W, skv = cur.skv, RS = cur.rs;
    const int j_lo = swa_jlo(cur.P0, W);
    int j_hi = (cur.P0 + QB - 1) / KVBLK + 1; if (j_hi > skv / KVBLK) j_hi = skv / KVBLK;
    const int NT = j_hi - j_lo;
    const int kbn = swa_jlo(nxt.P0, nxt.W) * KVBLK;
    const int qlo = cur.P0 + wid * QBLK, qm = qlo + r32 - 4 * hi;
    char* V_lds = lds; char* K_lds = lds + 2 * SHM_V;
    float* ws = (float*)(lds + 2 * SHM_V + 2 * SHM_K) + wid * 64; float* li_l = ws, * al_l = ws + 32;
    float m_reg = -1e30f, l_reg = 0; f32x16 o[4] = {};
    const int sr = tid >> 4, sc = (tid & 15) * 8, vst0 = v_st(sr, sc), vst1 = v_st(32 + sr, sc), kws = KSWZ(sr, sc * 2);
    const int vb0 = (int)(uintptr_t)V_lds + v_rd_base(lane);
    const bf16_t* Kh = cur.K; const bf16_t* Vh = cur.V;
#define RESC(a) do { if (__any((a) < 1.f)) { if (hi == 0) al_l[r32] = (a); asm volatile("s_waitcnt lgkmcnt(0)" ::: "memory");              \
                     for (int d_ = 0; d_ < 4; ++d_) for (int r = 0; r < 16; ++r) o[d_][r] *= al_l[crow(r, hi)]; } } while (0)
#define KBASE(t) ((j_lo + (t)) * KVBLK)
#define MASKT(P0_, P1_, t) do { const int kb_ = KBASE(t); if (kb_ + KVBLK - 1 > qlo || kb_ <= qlo + QBLK - 1 - W) mask_tile(P0_, P1_, qm - kb_, (unsigned)W); } while (0)
    constexpr int NQL = 8;
#define SEAM_K0() do { VMWN(NQL); SWRITE_HK(0); SBAR(); } while (0)
    f32x16 pA0, pA1, pB0, pB1; float mnA, mnB, alA, alB; bf16x8 pa0, pa1, pa2, pa3;
    SWRITE_HV(0); SBAR();
    if (NT > 1) { SLOAD_H(Kh, Vh, RS, KBASE(1)); }
    SBAR(); qkt<0>(pA0, pA1, K_lds, r32, hi, S.qr);
    MASKT(pA0, pA1, 0); partialSM(pA0, pA1, m_reg, mnA, alA);
    if (NT > 1) { VMW(); SWRITE_H(1); }
    __syncthreads();
#define HALF_STEP(PX0, PX1, mnX, alX, PY0, PY1, alY, t, KB, VB, SB) do {                                                      \
        SBAR(); qkt<KB>(PX0, PX1, K_lds, r32, hi, S.qr);                                                                      \
        finishSM(PY0, PY1, alY, l_reg, pa0, pa1, pa2, pa3); SBAR();                                                           \
        if ((t) + 1 < NT) { SLOAD_H(Kh, Vh, RS, KBASE((t) + 1)); SBAR(); }                                                    \
        pv_tile<VB>(o, vb0, pa0, pa1, pa2, pa3); MASKT(PX0, PX1, (t)); partialSM(PX0, PX1, m_reg, mnX, alX);                  \
        __syncthreads();                                                                                                      \
        if ((t) + 1 < NT) { VMW(); SWRITE_H(SB); }                                                                            \
        RESC(alX); __syncthreads(); } while (0)
    for (int t = 1; t + 1 < NT; t += 2) {
        HALF_STEP(pB0, pB1, mnB, alB, pA0, pA1, alA, t, 1, 0, 0);
        HALF_STEP(pA0, pA1, mnA, alA, pB0, pB1, alB, t + 1, 0, 1, 1);
    }
    const bool even = (NT & 1) == 0;
    if (even) { SBAR(); qkt<1>(pB0, pB1, K_lds, r32, hi, S.qr); SBAR(); }
    SLOAD_H(nxt.K, nxt.V, nxt.rs, kbn); SBAR();
#pragma unroll
    for (int d0 = 0; d0 < 8; ++d0) S.qr[d0] = ld8(nxt.Q + (size_t)(wid * QBLK + r32) * nxt.rs + d0 * 16 + hi * 8);
    SBAR();
    finishSM(pA0, pA1, alA, l_reg, pa0, pa1, pa2, pa3); SBAR();
    pv_tile<0>(o, vb0, pa0, pa1, pa2, pa3);
    if (even) { MASKT(pB0, pB1, NT - 1); partialSM(pB0, pB1, m_reg, mnB, alB); __syncthreads(); RESC(alB);
        finishSM(pB0, pB1, alB, l_reg, pa0, pa1, pa2, pa3); SBAR(); pv_tile<1>(o, vb0, pa0, pa1, pa2, pa3); }
    SBAR(); SEAM_K0();
    if (hi == 0) li_l[r32] = l_reg; asm volatile("s_waitcnt lgkmcnt(0)" ::: "memory");
    if (cur.LSE && hi == 0) cur.LSE[(size_t)(wid * QBLK + r32) * cur.ls] = m_reg * SCALE + __logf(l_reg);
    float rli[16];
#pragma unroll
    for (int r = 0; r < 16; ++r) rli[r] = __builtin_amdgcn_rcpf(li_l[crow(r, hi)]);
    bf16_t* Ow = cur.O + (size_t)(wid * QBLK) * cur.os;
#pragma unroll
    for (int r = 0; r < 16; ++r) { const int orow = crow(r, hi);
#pragma unroll
        for (int d0 = 0; d0 < 4; ++d0) { const float v = o[d0][r] * rli[r];
            const float vn = __shfl_xor(v, 1);
            if ((r32 & 1) == 0) *(unsigned*)(Ow + (size_t)orow * cur.os + d0 * 32 + r32) = cvtpk(v, vn); } }
    __syncthreads();
#undef RESC
#undef KBASE
#undef MASKT
#undef SEAM_K0
#undef HALF_STEP
}

struct WideRef { const bf16_t* Q; const bf16_t* K; const bf16_t* V; bf16_t* O; int rs, os, P0; };
constexpr int WIDE_K_OFF = 98304, WIDE_WS_OFF = 131072, WIDE_LDS_BYTES = WIDE_WS_OFF + NW * 64 * 4;
#define ATT_LAS __attribute__((address_space(3)))
__device__ __forceinline__ void attn_wide_block(const WideRef& cur, char* lds, ATT_LAS unsigned char* ldsl) {
    int tid_ = threadIdx.x; asm volatile("" : "+v"(tid_));
    const int tid = tid_, wid = __builtin_amdgcn_readfirstlane(tid >> 6), lane = tid & 63, r32 = lane & 31, hi = lane >> 5;
    const bool grpB = wid >= 4;
    const int RS = cur.rs;
    const int NT = cur.P0 / KVBLK + QB / KVBLK;
    const int qlo = cur.P0 + wid * QBLK, qm = qlo + r32 - 4 * hi;
    char* V_lds = lds; char* K_lds = lds + WIDE_K_OFF;
    float* ws = (float*)(lds + WIDE_WS_OFF) + wid * 64; float* li_l = ws, * al_l = ws + 32;
    const int vb0 = (int)(uintptr_t)V_lds + v_rd_base(lane);
    const int L = wid * 1024 + lane * 16;
    const int krow = L >> 8, kcol = ((L & 255) ^ ((krow & 7) << 4)) >> 1;
    const int vsub = L >> 9, vkk = (vsub >> 2) * 8 + ((L & 511) >> 6), vcol = (vsub & 3) * 32 + ((L & 63) >> 1);
    const int vkey = (vkk & ~0xC) | ((vkk & 4) << 1) | ((vkk & 8) >> 1);
    const unsigned offK = (unsigned)(krow * RS + kcol) * 2u, offV = (unsigned)(vkey * RS + vcol) * 2u;
    const size_t half32 = (size_t)32 * RS * 2;
    bf16x8 qr[8];
#pragma unroll
    for (int d0 = 0; d0 < 8; ++d0) qr[d0] = ld8(cur.Q + (size_t)(wid * QBLK + r32) * RS + d0 * 16 + hi * 8);
#define WDMA1(gp, ldsoff) __builtin_amdgcn_global_load_lds((const unsigned*)(gp), (ATT_LAS unsigned*)(ldsl + (ldsoff) + wid * 1024), 16, 0, 0)
#define WDMA(k0, kb, vb) do { const char* kq_ = (const char*)(cur.K + (size_t)(k0) * RS); const char* vq_ = (const char*)(cur.V + (size_t)(k0) * RS); \
        const int ko_ = WIDE_K_OFF + (kb) * SHM_K, vo_ = (vb) * 32768; \
        WDMA1(kq_ + offK, ko_); WDMA1(kq_ + half32 + offK, ko_ + 8192); \
        WDMA1(vq_ + offV, vo_); WDMA1(vq_ + half32 + offV, vo_ + 8192); \
        WDMA1(vq_ + 256 + offV, vo_ + 16384); WDMA1(vq_ + 256 + half32 + offV, vo_ + 16384 + 8192); } while (0)
    WDMA(0, 0, 0); asm volatile("s_waitcnt vmcnt(0)" ::: "memory");
    __syncthreads();
    float m_reg = -1e30f, l_reg = 0; f32x16 o[8] = {};
    bf16x8 pa0 = {}, pa1 = {}, pa2 = {}, pa3 = {};
    int v3 = 0;
#define WQK(t) do { f32x16 p0, p1; float mn, al; \
        qkt<0>(p0, p1, K_lds + ((t) & 1) * SHM_K, r32, hi, qr); \
        { const int kb_ = (t) * KVBLK; if (kb_ + KVBLK - 1 > qlo) mask_tile(p0, p1, qm - kb_, 1u << 30); } \
        partialSM(p0, p1, m_reg, mn, al); finishSM(p0, p1, al, l_reg, pa0, pa1, pa2, pa3); SBAR(); \
        if (__any(al < 1.f)) { if (hi == 0) al_l[r32] = al; asm volatile("s_waitcnt lgkmcnt(0)" ::: "memory"); \
            _Pragma("unroll") for (int d_ = 0; d_ < 8; ++d_) _Pragma("unroll") for (int r = 0; r < 16; ++r) o[d_][r] *= al_l[crow(r, hi)]; } } while (0)
#define WPV(vbuf) do { const int vbt_ = vb0 + (vbuf) * 32768; pv_tile<0, 16384>(o, vbt_, pa0, pa1, pa2, pa3); pv_tile<1, 16384>(o + 4, vbt_, pa0, pa1, pa2, pa3); SBAR(); } while (0)
    for (int t = 0; t < NT; ++t) {
        const int v3n = v3 == 2 ? 0 : v3 + 1, v3p = v3 == 0 ? 2 : v3 - 1;
        if (t + 1 < NT) { WDMA((t + 1) * KVBLK, (t + 1) & 1, v3n); } SBAR();
        if (grpB && t > 0) { WPV(v3p); }
        WQK(t);
        if (!grpB) { WPV(v3); }
        asm volatile("s_waitcnt vmcnt(0)" ::: "memory");
        __syncthreads();
        v3 = v3n;
    }
    if (grpB) { const int v3p = v3 == 0 ? 2 : v3 - 1; WPV(v3p); }
#undef WQK
#undef WPV
#undef WDMA
#undef WDMA1
    if (hi == 0) li_l[r32] = l_reg; asm volatile("s_waitcnt lgkmcnt(0)" ::: "memory");
    float rli[16];
#pragma unroll
    for (int r = 0; r < 16; ++r) rli[r] = __builtin_amdgcn_rcpf(li_l[crow(r, hi)]);
    bf16_t* Ow = cur.O + (size_t)(wid * QBLK) * cur.os;
#pragma unroll
    for (int r = 0; r < 16; ++r) { const int orow = crow(r, hi);
#pragma unroll
        for (int d0 = 0; d0 < 8; ++d0) { const float v = o[d0][r] * rli[r];
            const float vn = __shfl_xor(v, 1);
            if ((r32 & 1) == 0) *(unsigned*)(Ow + (size_t)orow * cur.os + d0 * 32 + r32) = cvtpk(v, vn); } }
    __syncthreads();
}
#undef VMW
#undef VMWN
#undef SLOAD_H
#undef SWRITE_HK
#undef SWRITE_HV
#undef SWRITE_H
}

#define GAS __attribute__((address_space(1)))
#define LAS __attribute__((address_space(3)))
typedef unsigned short bf16;
typedef unsigned v4u __attribute__((ext_vector_type(4)));
typedef unsigned v2u __attribute__((ext_vector_type(2)));
typedef float f32x4 __attribute__((ext_vector_type(4)));
#define LDS_WAIT() asm volatile("s_waitcnt lgkmcnt(0)" ::: "memory")
__device__ __forceinline__ unsigned f2bf(float f) { unsigned u = __builtin_bit_cast(unsigned, f); return (u + 0x7fffu + ((u >> 16) & 1u)) >> 16; }
__device__ __forceinline__ unsigned pk2(float lo, float hi) { return f2bf(lo) | (f2bf(hi) << 16); }
__device__ __forceinline__ float bflo(unsigned w) { return __uint_as_float(w << 16); }
__device__ __forceinline__ float bfhi(unsigned w) { return __uint_as_float(w & 0xffff0000u); }

#define XB_TMO      128
#define XB_XCNT(j)  (256  + 64 * (j))
#define XB_XSUB(j)  (1280 + 64 * (j))
#define XB_XGEN(j)  (2304 + 64 * (j))
#define XB_TOP      3328
#define XB_TOPGEN   3392
#define XCD_BAR_WORDS 3456
#define XB_SPIN_CAP (1u << 18)

__device__ __forceinline__ unsigned xb_ld(unsigned* p)              { return __hip_atomic_load(p, __ATOMIC_RELAXED, __HIP_MEMORY_SCOPE_AGENT); }
__device__ __forceinline__ unsigned xb_add(unsigned* p, unsigned v) { return __hip_atomic_fetch_add(p, v, __ATOMIC_RELAXED, __HIP_MEMORY_SCOPE_AGENT); }
__device__ __forceinline__ unsigned xb_xcc_id() { return (unsigned)__builtin_amdgcn_s_getreg((3 << 11) | 20) & 0xFu; }
#define XB_SPIN(cond, bar) do { unsigned _sp = 0; while (cond) { __builtin_amdgcn_s_sleep(1); \
    if ((++_sp & 255u) == 0u) { if (xb_ld(&(bar)[XB_TMO])) break; if (_sp > XB_SPIN_CAP) { atomicAdd(&(bar)[XB_TMO], 1u); break; } } } } while (0)

struct XcdBarrier {
    unsigned* bar; unsigned x;
    volatile LAS unsigned* st;
};

__device__ __forceinline__ XcdBarrier xcd_barrier_post(unsigned* bar, volatile LAS unsigned* st) {
    XcdBarrier b; b.bar = bar; b.x = xb_xcc_id(); b.st = st;
    if (threadIdx.x == 0) (void)xb_add(&bar[XB_XCNT(b.x)], 1u);
    return b;
}
__device__ __forceinline__ void xcd_barrier_complete(unsigned* bar, unsigned x, unsigned& nloc, unsigned& nx) {
    const unsigned G = gridDim.x * gridDim.y * gridDim.z;
    unsigned sum, cnt, mine, sp = 0u;
    for (;;) {
        sum = 0u; cnt = 0u; mine = 0u;
#pragma unroll
        for (unsigned j = 0; j < 16; ++j) { const unsigned c = xb_ld(&bar[XB_XCNT(j)]); sum += c; cnt += (c > 0u) ? 1u : 0u; mine = (j == x) ? c : mine; }
        if (sum == G) break;
        __builtin_amdgcn_s_sleep(1);
        if ((++sp & 255u) == 0u) { if (xb_ld(&bar[XB_TMO])) break; if (sp > XB_SPIN_CAP) { atomicAdd(&bar[XB_TMO], 1u); break; } }
    }
    nloc = mine > 0u ? mine : 1u; nx = cnt > 0u ? cnt : 1u;
}

__device__ __forceinline__ void xcd_barrier(const XcdBarrier& b) {
    asm volatile("s_waitcnt vmcnt(0)" ::: "memory");
    __syncthreads();
    if (threadIdx.x == 0) {
        unsigned* bar = b.bar;
        __builtin_amdgcn_s_waitcnt(0);
        unsigned nloc = b.st[0], nx = b.st[1];
        if (nloc == 0u) { xcd_barrier_complete(bar, b.x, nloc, nx); b.st[0] = nloc; b.st[1] = nx; }
        const unsigned old = xb_add(&bar[XB_XSUB(b.x)], 1u);
        const unsigned gen = old / nloc;
        if (old + 1u == (gen + 1u) * nloc) {
            __builtin_amdgcn_fence(__ATOMIC_RELEASE, "agent");
            asm volatile("s_waitcnt vmcnt(0)" ::: "memory");
            const unsigned og = xb_add(&bar[XB_TOP], 1u);
            const unsigned tg = og / nx;
            if (og + 1u == (tg + 1u) * nx) xb_add(&bar[XB_TOPGEN], 1u);
            else XB_SPIN(xb_ld(&bar[XB_TOPGEN]) == tg, bar);
            __builtin_amdgcn_fence(__ATOMIC_ACQUIRE, "agent");
            xb_add(&bar[XB_XGEN(b.x)], 1u);
            asm volatile("s_waitcnt vmcnt(0)" ::: "memory");
        } else {
            XB_SPIN(xb_ld(&bar[XB_XGEN(b.x)]) == gen, bar);
            __builtin_amdgcn_fence(__ATOMIC_ACQUIRE, "agent");
            asm volatile("s_waitcnt vmcnt(0)" ::: "memory");
        }
    }
    __syncthreads();
}
constexpr int NB = 4, SEQ = 4096, DM = 2048, M = NB * SEQ, DFF = 5632, NQKV = 7680, NGATE = 4096, DIN = NQKV + NGATE;
constexpr int NWAVES = 8;
constexpr float RMS_EPS = 1e-6f;
constexpr float LAM_INIT = 0.2f;
constexpr size_t MiB = 1u << 20;
constexpr size_t WS_QKV = 0, WS_GATES = 240 * MiB;
constexpr size_t WS_W1GU = 0, WS_W1D = 44 * MiB, WS_HID = 66 * MiB;
constexpr size_t WS_XB = 368 * MiB;
constexpr size_t WS_WIN = 432 * MiB;
constexpr size_t WS_ODIL_RAW = 432 * MiB;
constexpr size_t WS_LSE = 480 * MiB;
constexpr size_t WS_SS = 481 * MiB;
constexpr size_t WS_ROPE = 482 * MiB;
constexpr size_t WS_WOUT = 484 * MiB, WS_WDIL = 492 * MiB, WS_WDIFF = 494 * MiB;
constexpr size_t WS_W2GU = 0, WS_W2D = 44 * MiB, WS_ODIL = 66 * MiB, WS_ODIFF = 82 * MiB, WS_Y = 114 * MiB;
constexpr size_t WS_HID2 = 66 * MiB;
constexpr size_t WS_BAR = 498 * MiB, WS_BAR_BYTES = 16384;
constexpr size_t WS_END = 499 * MiB;
constexpr int LDS_MISC = 139264, LDS_BYTES = LDS_MISC + 256;

__device__ __forceinline__ float wave_sum(float v) {
#pragma unroll
    for (int o = 1; o < 64; o <<= 1) v += __shfl_xor(v, o);
    return v;
}
__device__ __forceinline__ unsigned cvtpk2(float lo, float hi) { unsigned r; asm volatile("v_cvt_pk_bf16_f32 %0, %1, %2" : "=v"(r) : "v"(lo), "v"(hi)); return r; }
__device__ __forceinline__ void transpose_mat(const float* W, int K, int N, const float* gain, bf16* WT, int mode, int gw, int NGW, int lane, int& ibase, LAS float* scr, int blk = 0, int ldk = 0, int koff = 0) {
    const int nkb = K / 64, nit = nkb * (N / 64);
    const int it0 = (gw - ibase % NGW + NGW) % NGW; ibase += nit;
    const int ln = (lane & 15) * 4, lk = lane >> 4, c = lane & 7, ns = lane >> 3;
    for (int it = it0; it < nit; it += NGW) {
        const int nb = it / nkb, kb = it - nb * nkb, k0 = kb * 64, n0 = nb * 64;
        const float* src = W + (size_t)(k0 + lk) * N + n0 + ln;
        f32x4 v[16];
#pragma unroll
        for (int i = 0; i < 16; ++i) v[i] = __builtin_nontemporal_load((const f32x4*)(src + (size_t)(4 * i) * N));
        if (gain) {
#pragma unroll
            for (int i = 0; i < 16; ++i) v[i] = v[i] * gain[k0 + 4 * i + lk];
        }
#pragma unroll
        for (int i = 0; i < 16; ++i) { LAS float* d = scr + (4 * i + lk) * 65 + ln; d[0] = v[i][0]; d[1] = v[i][1]; d[2] = v[i][2]; d[3] = v[i][3]; }
        LDS_WAIT(); asm volatile("" ::: "memory");
#pragma unroll
        for (int jj = 0; jj < 8; ++jj) { const int nl = ns + 8 * jj, n = n0 + nl; const LAS float* s = scr + (8 * c) * 65 + nl;
            const int row = mode == 0 ? n : ((n >> 7) * 256 + (mode == 2 ? 128 : 0) + (n & 127));
            v4u o; o.x = cvtpk2(s[0 * 65], s[1 * 65]); o.y = cvtpk2(s[2 * 65], s[3 * 65]); o.z = cvtpk2(s[4 * 65], s[5 * 65]); o.w = cvtpk2(s[6 * 65], s[7 * 65]);
            bf16* dst = blk ? WT + (size_t)(k0 >> 6) * ((size_t)blk * 64) + (size_t)row * 64 + 8 * c : WT + (size_t)row * (ldk ? ldk : K) + koff + k0 + 8 * c;
            if (mode == 0) __builtin_nontemporal_store(o, (v4u*)dst); else *(v4u*)dst = o; }
        LDS_WAIT(); asm volatile("" ::: "memory");
    }
}

#ifndef PG_ALIGN_BIG
#define PG_ALIGN_BIG true
#endif
struct Args { const float* in[24]; float* out; unsigned char* ws; int ph_lo, ph_hi; };
constexpr int NPHASE = 11;

__device__ __forceinline__ att::BlockRef attn_decode(int s, int w, int G, int nd, bf16* qkv, bf16* odiff_raw, bf16* odil_raw, float* lse) {
    att::BlockRef r;
    if (s < 2 * nd) {
        const int item = w + (s >> 1) * G, pass = s & 1, head = item >> 3, y = item & 7, qb = pass ? 15 - y : y;
        const int vh = head & 1, comp = (head >> 1) & 1, h = (head >> 2) & 3, b = head >> 4;
        bf16* base = qkv + (size_t)(b * SEQ) * NQKV;
        r.Q = base + 4608 + h * 256 + comp * 128 + (size_t)(qb * 256) * NQKV;
        r.K = base + 5632 + h * 256 + comp * 128;
        r.V = base + 6656 + h * 256 + vh * 128;
        r.O = odiff_raw + (size_t)comp * ((size_t)M * 1024) + (size_t)(b * SEQ + qb * 256) * 1024 + h * 256 + vh * 128;
        r.LSE = nullptr; r.rs = NQKV; r.os = 1024; r.ls = 0; r.P0 = qb * 256; r.W = 1 << 30; r.skv = SEQ;
    } else {
        const int blk = w + (s - 2 * nd) * G, g = blk >> 8, rem = blk & 255;
        const int dil = g == 0 ? 1 : (g == 1 ? 4 : 16), L = SEQ / dil, nqb = L / 256;
        const int qb = rem % nqb; int t = rem / nqb; const int c = t % dil; t /= dil; const int h = t & 3, b = t >> 2;
        const size_t tok0 = (size_t)b * SEQ + c;
        bf16* base = qkv + tok0 * NQKV + g * 512 + h * 128;
        r.Q = base + (size_t)(qb * 256) * ((size_t)dil * NQKV);
        r.K = base + 1536;
        r.V = base + 3072;
        r.O = odil_raw + (size_t)g * ((size_t)M * 512) + tok0 * 512 + h * 128 + (size_t)(qb * 256) * ((size_t)dil * 512);
        r.LSE = lse + (size_t)g * ((size_t)M * 4) + tok0 * 4 + h + (size_t)(qb * 256) * ((size_t)dil * 4);
        r.rs = dil * NQKV; r.os = dil * 512; r.ls = dil * 4; r.P0 = qb * 256; r.W = 129; r.skv = L;
    }
    return r;
}

__global__ void __launch_bounds__(NWAVES * 64, 2) layer_fwd(Args args) {
    extern __shared__ __attribute__((aligned(16))) unsigned char lds[];
    const int wave = __builtin_amdgcn_readfirstlane((int)threadIdx.x >> 6);
#define PHASE_TID() int tid_ = threadIdx.x; asm volatile("" : "+v"(tid_)); const int tid = tid_, lane = tid & 63; (void)lane
    const int G = gridDim.x, bx = blockIdx.x;
    const int vcu = (G % 8 == 0) ? (bx % 8) * (G / 8) + bx / 8 : bx;
    const int gw = vcu * NWAVES + wave, NGW = G * NWAVES;
    const int NTHR = G * NWAVES * 64;
    unsigned char* ws = args.ws;
    LAS unsigned char* ldsl = (LAS unsigned char*)lds;
    const int lo = args.ph_lo, hi = args.ph_hi;
#ifndef PHASE_MASK
#define PHASE_MASK 0x7ff
#endif
#define IN(k) (((PHASE_MASK >> (k)) & 1) && lo <= (k) && (k) < hi)
    volatile LAS unsigned* MISC = (volatile LAS unsigned*)(ldsl + LDS_MISC);
    if (threadIdx.x < 64) MISC[threadIdx.x] = 0u;
    __syncthreads();
    XcdBarrier bar = xcd_barrier_post((unsigned*)(ws + WS_BAR), MISC + 8);
#define SEAM(k) do { if (IN(k) && IN((k) + 1)) { if ((k) == 0) { asm volatile("s_waitcnt vmcnt(0)" ::: "memory"); cg::this_grid().sync(); } else xcd_barrier(bar); } STAMP(k); } while (0)
#ifndef PROBE_MASK
#define PROBE_MASK 0
#endif
#if PROBE_MASK
    unsigned long long t_prev = __builtin_amdgcn_s_memrealtime(), t_acc = 0; unsigned kl_save = 0; (void)kl_save;
#define STAMP(k) do { const unsigned long long t_now = __builtin_amdgcn_s_memrealtime(); if ((PROBE_MASK >> (k)) & 1) t_acc += t_now - t_prev; t_prev = t_now; } while (0)
#else
#define STAMP(k) do { } while (0)
#endif
    const float* x = args.in[0]; float* out = args.out;
    bf16* XB = (bf16*)(ws + WS_XB); bf16* HID = (bf16*)(ws + WS_HID); bf16* QKV = (bf16*)(ws + WS_QKV); bf16* GATES = (bf16*)(ws + WS_GATES);
    float* SS1 = (float*)(ws + WS_SS); float* SS2 = SS1 + M; float* SS3 = SS2 + M;
    float* COS = (float*)(ws + WS_ROPE); float* SIN = COS + (size_t)M * 16;
    float* LSE = (float*)(ws + WS_LSE);
    bf16* W2GU = (bf16*)out + (size_t)32 * 1024 * 1024;
    const int nwg3 = (M / 256) * (DIN / 256), rounds3 = (nwg3 + G - 1) / G, first_idle3 = nwg3 - (rounds3 - 1) * G;
    const bool w2gu_in_p3 = first_idle3 < G;
    bf16* ODIFF_RAW = (bf16*)out;     bf16* ODIL_RAW = (bf16*)(ws + WS_ODIL_RAW);
    bf16* ODIL = (bf16*)(ws + WS_ODIL); bf16* ODIFF = (bf16*)(ws + WS_ODIFF); bf16* Y = (bf16*)(ws + WS_Y);

    if (IN(0)) {
        PHASE_TID(); const int gtid = bx * (NWAVES * 64) + tid;
        int ibase = 0; LAS float* scr = (LAS float*)(ldsl + wave * 16640);
        transpose_mat(args.in[3], DM, DFF, args.in[2], (bf16*)(ws + WS_W1GU), 1, gw, NGW, lane, ibase, scr);
        transpose_mat(args.in[4], DM, DFF, args.in[2], (bf16*)(ws + WS_W1GU), 2, gw, NGW, lane, ibase, scr);
        transpose_mat(args.in[5], DFF, DM, nullptr, (bf16*)(ws + WS_W1D), 0, gw, NGW, lane, ibase, scr);
        transpose_mat(args.in[7], DM, DIN, args.in[6], (bf16*)(ws + WS_WIN), 0, gw, NGW, lane, ibase, scr);
        transpose_mat(args.in[17], 512, DM, nullptr, (bf16*)(ws + WS_WDIL), 0, gw, NGW, lane, ibase, scr, 0, 1536, 0);
        transpose_mat(args.in[18], 1024, DM, nullptr, (bf16*)(ws + WS_WDIL), 0, gw, NGW, lane, ibase, scr, 0, 1536, 512);
        transpose_mat(args.in[19], DM, DM, nullptr, (bf16*)(ws + WS_WOUT), 0, gw, NGW, lane, ibase, scr);
        for (int m = gw; m < M; m += NGW) {
            const f32x4* xr = (const f32x4*)(x + (size_t)m * DM) + lane; f32x4 v[8]; float s = 0.f;
#pragma unroll
            for (int j = 0; j < 8; ++j) { v[j] = __builtin_nontemporal_load(xr + 64 * j); s += (v[j].x * v[j].x + v[j].y * v[j].y) + (v[j].z * v[j].z + v[j].w * v[j].w); }
            s = wave_sum(s); if (lane == 0) SS1[m] = s;
            v2u* o8 = (v2u*)(XB + (size_t)m * DM) + lane;
#pragma unroll
            for (int j = 0; j < 8; ++j) { v2u w; w.x = pk2(v[j].x, v[j].y); w.y = pk2(v[j].z, v[j].w); o8[64 * j] = w; }
        }
        for (int i = gtid; i < 2 * M; i += NTHR) SS2[i] = 0.f;
        const int* pos = (const int*)args.in[1];
        for (int idx = gtid; idx < M * 16; idx += NTHR) { const int t = idx >> 4, i = idx & 15;
            const float inv = __builtin_amdgcn_exp2f((float)i * (-1.0f / 16.0f) * 18.931568569324174f);
            const float ang = (float)pos[t] * inv;
            const double rev = (double)ang * 0.15915494309189535; const float fr = (float)(rev - __builtin_rint(rev));
            COS[idx] = __builtin_amdgcn_cosf(fr); SIN[idx] = __builtin_amdgcn_sinf(fr); }
    }
    SEAM(0);
#ifdef PROBE_KLOOP
    if (PROBE_KLOOP == 1 && threadIdx.x == 0) MISC[16] = 0u;
#endif
    if (IN(1)) {
        pg8::Gemm g{XB, (bf16*)(ws + WS_W1GU), M, 2 * DFF, DM}; pg8::StaticOrder So; So.init(M, 2 * DFF, G, bx);
        pg8::EpiSwiglu<false> E{HID, DFF, SS1, M};
        pg8::gemm_phase<pg8::EpiSwiglu<false>, pg8::StaticOrder, PG_ALIGN_BIG, true>(ldsl, g, So, E);
    }
    SEAM(1);
#ifdef PROBE_KLOOP
    if (PROBE_KLOOP == 1 && threadIdx.x == 0) { kl_save = MISC[16]; }
#endif
    if (IN(2)) {
        pg8::Gemm g{HID, (bf16*)(ws + WS_W1D), M, DM, DFF}; pg8::StaticOrder So; So.init(M, DM, G, bx, 4);
        pg8::EpiResid<true, false, false> E{x, nullptr, XB, SS2, 0.5f, DM};
        pg8::gemm_phase<pg8::EpiResid<true, false, false>, pg8::StaticOrder, true, true>(ldsl, g, So, E);
    }
    SEAM(2);
    if (IN(3)) {
        pg8::Gemm g{XB, (bf16*)(ws + WS_WIN), M, DIN, DM}; pg8::StaticOrder So; So.init(M, DIN, G, bx);
        pg8::EpiProj E{QKV, NQKV, GATES, NGATE, NQKV / 256, SS2, args.in[8], args.in[9], args.in[10], args.in[11], COS, SIN, (LAS float*)(ldsl + 131072)};
        pg8::gemm_phase<pg8::EpiProj, pg8::StaticOrder, true, true>(ldsl, g, So, E);
        if (w2gu_in_p3 && bx >= first_idle3) {
            PHASE_TID(); const int gwi = (bx - first_idle3) * NWAVES + wave, NGWI = (G - first_idle3) * NWAVES; int ibase = 0; LAS float* scr = (LAS float*)(ldsl + wave * 16640);
            transpose_mat(args.in[21], DM, DFF, args.in[20], W2GU, 1, gwi, NGWI, lane, ibase, scr);
            transpose_mat(args.in[22], DM, DFF, args.in[20], W2GU, 2, gwi, NGWI, lane, ibase, scr);
        }
    }
    SEAM(3);
    if (IN(5)) {
        const int w = vcu;
        for (int i = w; i < 256; i += G) {
            const int head = i >> 3, y = i & 7, comp = head & 1, h = (head >> 1) & 3, b = head >> 3;
            bf16* base = QKV + (size_t)(b * SEQ) * NQKV;
            for (int pass = 0; pass < 2; ++pass) { const int qb = pass ? y : 15 - y;
                att::WideRef r; r.Q = base + 4608 + h * 256 + comp * 128 + (size_t)(qb * 256) * NQKV; r.K = base + 5632 + h * 256 + comp * 128; r.V = base + 6656 + h * 256;
                r.O = ODIFF_RAW + (size_t)comp * ((size_t)M * 1024) + (size_t)(b * SEQ + qb * 256) * 1024 + h * 256; r.rs = NQKV; r.os = 1024; r.P0 = qb * 256;
                att::attn_wide_block(r, (char*)lds, ldsl); }
        }
        const int nd = 0, ndl = w < 768 ? (768 - w + G - 1) / G : 0, total = ndl;
        if (total > 0) {
            att::Seam S;
            { const att::BlockRef c0 = attn_decode(0, w, G, nd, QKV, ODIFF_RAW, ODIL_RAW, LSE); att::attn_prime(c0, (char*)lds, S); }
            for (int s = 0; s < total; ++s) {
                const att::BlockRef cur = attn_decode(s, w, G, nd, QKV, ODIFF_RAW, ODIL_RAW, LSE);
                const att::BlockRef nxt = attn_decode(s + 1 < total ? s + 1 : s, w, G, nd, QKV, ODIFF_RAW, ODIL_RAW, LSE);
                att::attn_block(cur, nxt, (char*)lds, S);
            }
        }
    }
    SEAM(5);
    if (IN(6)) {
        PHASE_TID();
        int ibase = 0; LAS float* scr = (LAS float*)(ldsl + wave * 16640);
        if (!w2gu_in_p3) {
            transpose_mat(args.in[21], DM, DFF, args.in[20], W2GU, 1, gw, NGW, lane, ibase, scr);
            transpose_mat(args.in[22], DM, DFF, args.in[20], W2GU, 2, gw, NGW, lane, ibase, scr);
        }
        transpose_mat(args.in[23], DFF, DM, nullptr, (bf16*)(ws + WS_W2D), 0, gw, NGW, lane, ibase, scr);
        float lam;
        { const float a = args.in[12][lane] * args.in[13][lane] + args.in[12][lane + 64] * args.in[13][lane + 64];
          const float b = args.in[14][lane] * args.in[15][lane] + args.in[14][lane + 64] * args.in[15][lane + 64];
          lam = __expf(wave_sum(a)) - __expf(wave_sum(b)) + LAM_INIT; }
        const float* subln = args.in[16];
        for (int t = gw; t < M; t += NGW) {
            {
                const int h = lane >> 4;
                const float l0 = LSE[(size_t)t * 4 + h], l1 = LSE[(size_t)M * 4 + (size_t)t * 4 + h], l2 = LSE[(size_t)M * 8 + (size_t)t * 4 + h];
                const float mx = fmaxf(l0, fmaxf(l1, l2)); const float e0 = __expf(l0 - mx), e1 = __expf(l1 - mx), e2 = __expf(l2 - mx); const float inv = 1.0f / (e0 + e1 + e2);
                const float w0 = e0 * inv, w1 = e1 * inv, w2 = e2 * inv;
                const size_t off = (size_t)t * 512 + lane * 8, offo = (size_t)t * 1536 + lane * 8;
                const v4u a = __builtin_nontemporal_load((const v4u*)(ODIL_RAW + off)), b = __builtin_nontemporal_load((const v4u*)(ODIL_RAW + (size_t)M * 512 + off)), c = __builtin_nontemporal_load((const v4u*)(ODIL_RAW + (size_t)M * 1024 + off));
                v4u o;
                o.x = pk2(w0 * bflo(a.x) + w1 * bflo(b.x) + w2 * bflo(c.x), w0 * bfhi(a.x) + w1 * bfhi(b.x) + w2 * bfhi(c.x));
                o.y = pk2(w0 * bflo(a.y) + w1 * bflo(b.y) + w2 * bflo(c.y), w0 * bfhi(a.y) + w1 * bfhi(b.y) + w2 * bfhi(c.y));
                o.z = pk2(w0 * bflo(a.z) + w1 * bflo(b.z) + w2 * bflo(c.z), w0 * bfhi(a.z) + w1 * bfhi(b.z) + w2 * bfhi(c.z));
                o.w = pk2(w0 * bflo(a.w) + w1 * bflo(b.w) + w2 * bflo(c.w), w0 * bfhi(a.w) + w1 * bfhi(b.w) + w2 * bfhi(c.w));
                *(v4u*)(ODIL + offo) = o;
            }
#pragma unroll
            for (int hh = 0; hh < 2; ++hh) {
                const int l32 = lane & 31;
                const size_t off = (size_t)t * 1024 + (size_t)(hh * 2 + (lane >> 5)) * 256 + l32 * 8;
                const v4u a = __builtin_nontemporal_load((const v4u*)(ODIFF_RAW + off)), b = __builtin_nontemporal_load((const v4u*)(ODIFF_RAW + (size_t)M * 1024 + off));
                float d[8] = {bflo(a.x) - lam * bflo(b.x), bfhi(a.x) - lam * bfhi(b.x), bflo(a.y) - lam * bflo(b.y), bfhi(a.y) - lam * bfhi(b.y),
                              bflo(a.z) - lam * bflo(b.z), bfhi(a.z) - lam * bfhi(b.z), bflo(a.w) - lam * bflo(b.w), bfhi(a.w) - lam * bfhi(b.w)};
                float s = 0.f;
#pragma unroll
                for (int i = 0; i < 8; ++i) s += d[i] * d[i];
                s += __shfl_xor(s, 1); s += __shfl_xor(s, 2); s += __shfl_xor(s, 4); s += __shfl_xor(s, 8); s += __shfl_xor(s, 16);
                const float rs = rsqrtf(s * (1.0f / 256.0f) + RMS_EPS) * (1.0f - LAM_INIT);
                const f32x4 g0 = *(const f32x4*)(subln + l32 * 8), g1 = *(const f32x4*)(subln + l32 * 8 + 4);
                v4u o; o.x = pk2(d[0] * rs * g0[0], d[1] * rs * g0[1]); o.y = pk2(d[2] * rs * g0[2], d[3] * rs * g0[3]);
                o.z = pk2(d[4] * rs * g1[0], d[5] * rs * g1[1]); o.w = pk2(d[6] * rs * g1[2], d[7] * rs * g1[3]);
                *(v4u*)(ODIL + (size_t)t * 1536 + 512 + (size_t)(hh * 2 + (lane >> 5)) * 256 + l32 * 8) = o;
            }
        }
    }
    SEAM(6);
    if (IN(7)) {
        pg8::Gemm g{ODIL, (bf16*)(ws + WS_WDIL), M, DM, 1536}; pg8::StaticOrder So; So.init(M, DM, G, bx, 4);
        pg8::EpiGateMerge E{GATES, NGATE, Y, DM, 512 / 64};
        pg8::gemm_phase<pg8::EpiGateMerge, pg8::StaticOrder, true, true>(ldsl, g, So, E);
    }
    SEAM(7);
    if (IN(8)) {
        pg8::Gemm g{Y, (bf16*)(ws + WS_WOUT), M, DM, DM}; pg8::StaticOrder So; So.init(M, DM, G, bx, 4);
        pg8::EpiResid<false, false> E{XB, nullptr, XB, SS3, 1.0f, DM};
        pg8::gemm_phase<pg8::EpiResid<false, false>, pg8::StaticOrder, true, true>(ldsl, g, So, E);
    }
    SEAM(8);
    if (IN(9)) {
        pg8::Gemm g{XB, W2GU, M, 2 * DFF, DM}; pg8::StaticOrder So; So.init(M, 2 * DFF, G, bx);
        pg8::EpiSwiglu<false> E{(bf16*)(ws + WS_HID2), DFF, SS3, M};
        pg8::gemm_phase<pg8::EpiSwiglu<false>, pg8::StaticOrder, PG_ALIGN_BIG, true>(ldsl, g, So, E);
    }
    SEAM(9);
#ifdef PROBE_KLOOP
    if (PROBE_KLOOP == 10 && threadIdx.x == 0) MISC[16] = 0u;
#endif
    if (IN(10)) {
        pg8::Gemm g{(bf16*)(ws + WS_HID2), (bf16*)(ws + WS_W2D), M, DM, DFF}; pg8::StaticOrder So; So.init(M, DM, G, bx, 4);
        pg8::EpiResid<false, true, false> E{XB, out, nullptr, nullptr, 0.5f, DM};
        pg8::gemm_phase<pg8::EpiResid<false, true, false>, pg8::StaticOrder, true, true>(ldsl, g, So, E);
    }
    STAMP(10);
#ifdef PROBE_KLOOP
    t_acc = 0; if (threadIdx.x == 0) t_acc = (PROBE_KLOOP == 1) ? kl_save : MISC[16];
#endif
#if PROBE_MASK
    if (bx == 0 && threadIdx.x == 0) { const unsigned long long t0 = __builtin_amdgcn_s_memrealtime(); while (__builtin_amdgcn_s_memrealtime() - t0 < t_acc) __builtin_amdgcn_s_sleep(8); }
#endif
#undef IN
#undef SEAM
}

extern "C" void kernel_launch(void* const* d_in, const int* in_sizes, int n_in, void* d_out, int out_size, void* d_ws, size_t ws_size, hipStream_t stream) {
    static int grid = 0;
    if (grid == 0) {
        if (n_in != 24 || in_sizes[0] != M * DM || out_size != M * DM || ws_size < WS_END) {
            fprintf(stderr, "kernel_launch: unexpected shapes (n_in %d, in0 %d, out %d, ws %zu, need %zu)\n", n_in, n_in > 0 ? in_sizes[0] : -1, out_size, ws_size, (size_t)WS_END); grid = -1; return; }
        int dev = 0, cus = 0, per_cu = 0;
        if (hipGetDevice(&dev) != hipSuccess || hipDeviceGetAttribute(&cus, hipDeviceAttributeMultiprocessorCount, dev) != hipSuccess) { grid = -1; return; }
        if (hipFuncSetAttribute((const void*)layer_fwd, hipFuncAttributeMaxDynamicSharedMemorySize, LDS_BYTES) != hipSuccess) { fprintf(stderr, "kernel_launch: hipFuncSetAttribute failed\n"); grid = -1; return; }
        if (hipOccupancyMaxActiveBlocksPerMultiprocessor(&per_cu, (const void*)layer_fwd, NWAVES * 64, LDS_BYTES) != hipSuccess || per_cu < 1) { fprintf(stderr, "kernel_launch: occupancy query says %d\n", per_cu); per_cu = 1; }
        (void)hipGetLastError();
        grid = cus * per_cu;
    }
    if (grid < 0) return;
    if (hipMemsetAsync((char*)d_ws + WS_BAR, 0, WS_BAR_BYTES, stream) != hipSuccess) { fprintf(stderr, "kernel_launch: memset of the barrier words failed\n"); return; }
    Args a{};
    for (int i = 0; i < 24; ++i) a.in[i] = (const float*)d_in[i];
    a.out = (float*)d_out; a.ws = (unsigned char*)d_ws;
#if ONE_LAUNCH
    a.ph_lo = 0; a.ph_hi = NPHASE;
    void* kargs[] = {&a};
    hipError_t e = hipLaunchCooperativeKernel((const void*)layer_fwd, dim3(grid), dim3(NWAVES * 64), kargs, LDS_BYTES, stream);
    if (e != hipSuccess) fprintf(stderr, "kernel_launch: cooperative launch failed: %s (grid %d)\n", hipGetErrorString(e), grid);
#else
    for (int p = 0; p < NPHASE; ++p) { a.ph_lo = p; a.ph_hi = p + 1;
        hipLaunchKernelGGL(layer_fwd, dim3(grid), dim3(NWAVES * 64), LDS_BYTES, stream, a); }
#endif
}
```
